# Optimizing an MI355X kernel written in HIP

```python
import jax, jax.numpy as jnp
from jax import lax
import numpy as np

D_MODEL = 1024
BATCH = 8
SEQ = 4096
DEPTH = 2

CTX_LEN = 256
GRID_W = 64
N_MIXERS = 2
N_POOL_LAYERS = (DEPTH + 1) // 2
N_LRU_LAYERS = DEPTH // 2
POOL_WINDOWS = (2, 4, 8, 16)
N_POOL_GROUPS = 4
POOL_GROUP = D_MODEL // N_POOL_GROUPS
D_RNN = D_MODEL
N_LRU_BLOCKS = 4
LRU_BLOCK = D_RNN // N_LRU_BLOCKS
CONV_WIDTH = 4
CONV_LEFT = 2
LRU_C = 8.0
N_EXPERTS = 32
TOP_K = 4
D_FF = D_MODEL
SWIGLU_LIMIT = 7.0
SWIGLU_ALPHA = 1.702
EXPERT_BLOCK = 128
NORM_EPS = 1e-6

kernel_name = 'hybrid_pool_rglru_moe_prefix_dit'


def rms_norm(x, g):
    xf = x.astype(jnp.float32)
    y = xf * lax.rsqrt(jnp.mean(xf * xf, axis=-1, keepdims=True) + NORM_EPS)
    return (y * g.astype(jnp.float32)).astype(x.dtype)


def modulate(x, shift, scale):
    return x * (1.0 + scale) + shift


def window_bounds(n, w):
    idx = jnp.arange(n)
    return jnp.clip(idx - w // 2, 0, n), jnp.clip(idx + w // 2, 0, n)


def pool_grid(h, w):
    B, T, C = h.shape
    rows = T // GRID_W
    g = h.astype(jnp.float32).reshape(B, rows, GRID_W, C)
    sat = jnp.pad(jnp.cumsum(jnp.cumsum(g, axis=1), axis=2), ((0, 0), (1, 0), (1, 0), (0, 0)))
    r0, r1 = window_bounds(rows, w)
    c0, c1 = window_bounds(GRID_W, w)

    def corner(ri, ci):
        return jnp.take(jnp.take(sat, ri, axis=1), ci, axis=2)

    total = corner(r1, c1) - corner(r0, c1) - corner(r1, c0) + corner(r0, c0)
    count = ((r1 - r0)[:, None] * (c1 - c0)[None, :]).astype(jnp.float32)
    return (total / count[None, :, :, None]).reshape(B, T, C).astype(h.dtype)


def pool_seq(h, w):
    T = h.shape[1]
    cs = jnp.pad(jnp.cumsum(h.astype(jnp.float32), axis=1), ((0, 0), (1, 0), (0, 0)))
    lo, hi = window_bounds(T, w)
    total = jnp.take(cs, hi, axis=1) - jnp.take(cs, lo, axis=1)
    count = (hi - lo).astype(jnp.float32)
    return (total / count[None, :, None]).astype(h.dtype)


def pool_mixer(h, w_grp, scale, pool_fn):
    B, T, D = h.shape
    diffs = []
    for gi, w in enumerate(POOL_WINDOWS):
        hg = h[..., gi * POOL_GROUP:(gi + 1) * POOL_GROUP]
        diffs.append(pool_fn(hg, w) - hg)
    d = jnp.stack(diffs, axis=2)
    y = jnp.einsum('btgc,gcd->btgd', d, w_grp).reshape(B, T, D)
    return y * scale


def depthwise_conv(x, w, b):
    T = x.shape[1]
    xp = jnp.pad(x, ((0, 0), (CONV_LEFT, CONV_WIDTH - 1 - CONV_LEFT), (0, 0)))
    y = xp[:, 0:T] * w[0]
    for k in range(1, CONV_WIDTH):
        y = y + xp[:, k:k + T] * w[k]
    return y + b


def rglru_coeffs(u, w_r, b_r, w_i, b_i, lam):
    B, T, _ = u.shape
    ub = u.reshape(B, T, N_LRU_BLOCKS, LRU_BLOCK)
    r = jax.nn.sigmoid(jnp.einsum('btnd,nde->btne', ub, w_r).reshape(B, T, D_RNN) + b_r)
    i = jax.nn.sigmoid(jnp.einsum('btnd,nde->btne', ub, w_i).reshape(B, T, D_RNN) + b_i)
    log_a = -LRU_C * r.astype(jnp.float32) * jax.nn.softplus(-lam.astype(jnp.float32))
    a = jnp.exp(log_a)
    mult = jnp.sqrt(-jnp.expm1(2.0 * log_a))
    return a, mult * (i * u).astype(jnp.float32)


def linear_scan(a, b, h0, reverse):
    if h0 is not None:
        edge = -1 if reverse else 0
        b = b.at[:, edge].add(a[:, edge] * h0)

    def combine(p, q):
        a1, b1 = p
        a2, b2 = q
        return a1 * a2, a2 * b1 + b2

    _, h = lax.associative_scan(combine, (a, b), axis=1, reverse=reverse)
    return h


def lru_mixer(hl, hc, w_in, conv_w, conv_b, w_r, b_r, w_i, b_i, lam, w_out, need_ctx_out):
    gate_l, u_l = jnp.split(hl @ w_in, 2, axis=-1)
    u_l = depthwise_conv(u_l, conv_w, conv_b)
    u_c = depthwise_conv(hc @ w_in[:, D_RNN:], conv_w, conv_b)
    outs_l, outs_c = [], []
    for d, rev in enumerate((False, True)):
        a_c, b_c = rglru_coeffs(u_c, w_r[d], b_r[d], w_i[d], b_i[d], lam[d])
        h_c = linear_scan(a_c, b_c, None, rev)
        h0 = h_c[:, 0] if rev else h_c[:, -1]
        a_l, b_l = rglru_coeffs(u_l, w_r[d], b_r[d], w_i[d], b_i[d], lam[d])
        outs_l.append(linear_scan(a_l, b_l, h0, rev))
        outs_c.append(h_c)
    rec_l = (outs_l[0] + outs_l[1]).astype(hl.dtype)
    y_l = (jax.nn.gelu(gate_l) * rec_l) @ w_out
    if not need_ctx_out:
        return y_l, None
    rec_c = (outs_c[0] + outs_c[1]).astype(hc.dtype)
    y_c = (jax.nn.gelu(hc @ w_in[:, :D_RNN]) * rec_c) @ w_out
    return y_l, y_c


def moe(h, w_router, b_router, w_gu, b_gu, w_down, b_down):
    N, D = h.shape
    logits = (h @ w_router + b_router).astype(jnp.float32)
    top_val, top_idx = lax.top_k(logits, TOP_K)
    gate = jax.nn.softmax(top_val, axis=-1).astype(h.dtype)
    NK = N * TOP_K
    flat_e = top_idx.reshape(NK)
    flat_tok = jnp.arange(NK, dtype=jnp.int32) // TOP_K
    flat_w = gate.reshape(NK)
    order = jnp.argsort(flat_e)
    e_sorted, tok_sorted, w_sorted = flat_e[order], flat_tok[order], flat_w[order]
    counts = jnp.bincount(flat_e, length=N_EXPERTS)
    padded = (counts + EXPERT_BLOCK - 1) // EXPERT_BLOCK * EXPERT_BLOCK
    pad_end = jnp.cumsum(padded)
    pad_start = pad_end - padded
    start = jnp.cumsum(counts) - counts
    dest = pad_start[e_sorted] + jnp.arange(NK, dtype=jnp.int32) - start[e_sorted]
    n_blocks = (NK + N_EXPERTS * (EXPERT_BLOCK - 1) + EXPERT_BLOCK - 1) // EXPERT_BLOCK
    n_rows = n_blocks * EXPERT_BLOCK
    row_tok = jnp.full((n_rows,), N, dtype=jnp.int32).at[dest].set(tok_sorted)
    h_pad = jnp.concatenate([h, jnp.zeros((1, D), h.dtype)], axis=0)
    xb = h_pad[row_tok].reshape(n_blocks, EXPERT_BLOCK, D)
    block_start = jnp.arange(n_blocks, dtype=jnp.int32) * EXPERT_BLOCK
    block_e = jnp.minimum(jnp.searchsorted(pad_end, block_start, side='right'), N_EXPERTS - 1)

    def expert_block(args):
        xblk, e = args
        gu = xblk @ w_gu[e] + b_gu[e]
        g, u = gu[:, :D_FF], gu[:, D_FF:]
        g = jnp.minimum(g, SWIGLU_LIMIT)
        u = jnp.clip(u, -SWIGLU_LIMIT, SWIGLU_LIMIT)
        act = (u + 1.0) * g * jax.nn.sigmoid(SWIGLU_ALPHA * g)
        return act @ w_down[e] + b_down[e]

    y = lax.map(expert_block, (xb, block_e)).reshape(n_rows, D)
    return jnp.zeros((N, D), h.dtype).at[tok_sorted].add(y[dest] * w_sorted[:, None])


def setup_inputs(seed: int = 0) -> dict:
    key = jax.random.key(seed)
    ks = iter(jax.random.split(key, 32))
    D, E, F = D_MODEL, N_EXPERTS, D_FF

    def nrm(shape, scale):
        return scale * jax.random.normal(next(ks), shape, jnp.float32)

    def gain(shape):
        return 1.0 + nrm(shape, 0.05)

    a0 = jax.random.uniform(next(ks), (N_LRU_LAYERS, 2, D_RNN), jnp.float32, 0.9, 0.999)
    return {
        'x': nrm((BATCH, SEQ, D), 1.0),
        'c': nrm((BATCH, D), 1.0),
        'ctx': nrm((BATCH, CTX_LEN, D), 1.0),
        'c_ctx': nrm((D,), 1.0),
        'ada_w': nrm((DEPTH, D, 6 * D), 0.5 * D ** -0.5),
        'ada_b': nrm((DEPTH, 6 * D), 0.01),
        'norm_mix': gain((DEPTH, D)),
        'norm_ffn': gain((DEPTH, D)),
        'pool_w': nrm((N_POOL_LAYERS, N_POOL_GROUPS, POOL_GROUP, POOL_GROUP), POOL_GROUP ** -0.5),
        'pool_scale': gain((N_POOL_LAYERS, D)),
        'lru_w_in': nrm((N_LRU_LAYERS, D, 2 * D_RNN), D ** -0.5),
        'lru_conv_w': nrm((N_LRU_LAYERS, CONV_WIDTH, D_RNN), CONV_WIDTH ** -0.5),
        'lru_conv_b': nrm((N_LRU_LAYERS, D_RNN), 0.01),
        'lru_w_r': nrm((N_LRU_LAYERS, 2, N_LRU_BLOCKS, LRU_BLOCK, LRU_BLOCK), LRU_BLOCK ** -0.5),
        'lru_b_r': nrm((N_LRU_LAYERS, 2, D_RNN), 0.01),
        'lru_w_i': nrm((N_LRU_LAYERS, 2, N_LRU_BLOCKS, LRU_BLOCK, LRU_BLOCK), LRU_BLOCK ** -0.5),
        'lru_b_i': nrm((N_LRU_LAYERS, 2, D_RNN), 0.01),
        'lru_lam': jnp.log(a0) - jnp.log1p(-a0),
        'lru_w_out': nrm((N_LRU_LAYERS, D_RNN, D), D_RNN ** -0.5),
        'router_w': nrm((DEPTH, D, E), D ** -0.5),
        'router_b': nrm((DEPTH, E), 0.01),
        'exp_w_gu': nrm((DEPTH, E, D, 2 * F), D ** -0.5),
        'exp_b_gu': nrm((DEPTH, E, 2 * F), 0.01),
        'exp_w_down': nrm((DEPTH, E, F, D), F ** -0.5),
        'exp_b_down': nrm((DEPTH, E, D), 0.01),
        'final_norm': gain((D,)),
    }


def reference(x, c, ctx, c_ctx, ada_w, ada_b, norm_mix, norm_ffn, pool_w, pool_scale,
              lru_w_in, lru_conv_w, lru_conv_b, lru_w_r, lru_b_r, lru_w_i, lru_b_i, lru_lam, lru_w_out,
              router_w, router_b, exp_w_gu, exp_b_gu, exp_w_down, exp_b_down, final_norm):
    B, T, D = x.shape
    lat, cx = x, ctx
    silu_c = jax.nn.silu(c)
    silu_cc = jax.nn.silu(c_ctx)
    for i in range(DEPTH):
        last = i == DEPTH - 1
        is_pool = i % N_MIXERS == 0
        j = i // N_MIXERS
        need_ctx_out = not last
        need_ctx_in = need_ctx_out or not is_pool
        sh1, sc1, g1, sh2, sc2, g2 = jnp.split((silu_c @ ada_w[i] + ada_b[i])[:, None, :], 6, axis=-1)
        csh1, csc1, cg1, csh2, csc2, cg2 = jnp.split(silu_cc @ ada_w[i] + ada_b[i], 6)

        hl = modulate(rms_norm(lat, norm_mix[i]), sh1, sc1)
        hc = modulate(rms_norm(cx, norm_mix[i]), csh1, csc1) if need_ctx_in else None
        if is_pool:
            yl = pool_mixer(hl, pool_w[j], pool_scale[j], pool_grid)
            yc = pool_mixer(hc, pool_w[j], pool_scale[j], pool_seq) if need_ctx_out else None
        else:
            yl, yc = lru_mixer(hl, hc, lru_w_in[j], lru_conv_w[j], lru_conv_b[j], lru_w_r[j], lru_b_r[j],
                               lru_w_i[j], lru_b_i[j], lru_lam[j], lru_w_out[j], need_ctx_out)
        lat = lat + g1 * yl

        hl = modulate(rms_norm(lat, norm_ffn[i]), sh2, sc2)
        if need_ctx_out:
            cx = cx + cg1 * yc
            hc = modulate(rms_norm(cx, norm_ffn[i]), csh2, csc2)
            tokens = jnp.concatenate([hl.reshape(-1, D), hc.reshape(-1, D)], axis=0)
            y = moe(tokens, router_w[i], router_b[i], exp_w_gu[i], exp_b_gu[i], exp_w_down[i], exp_b_down[i])
            lat = lat + g2 * y[:B * T].reshape(B, T, D)
            cx = cx + cg2 * y[B * T:].reshape(cx.shape)
        else:
            y = moe(hl.reshape(-1, D), router_w[i], router_b[i], exp_w_gu[i], exp_b_gu[i], exp_w_down[i], exp_b_down[i])
            lat = lat + g2 * y.reshape(B, T, D)
    return rms_norm(lat, final_norm)
```

```cpp
#include <hip/hip_runtime.h>
#include <hip/hip_cooperative_groups.h>
#include <cstdio>
#include <cstdint>
namespace cg = cooperative_groups;

#ifndef N_LAUNCH_MODE
#define N_LAUNCH_MODE 1
#endif

#define LAS __attribute__((address_space(3)))
typedef unsigned short bf16_t;
typedef short bf16x8 __attribute__((ext_vector_type(8)));
typedef float f32x4 __attribute__((ext_vector_type(4)));
typedef float f32x2 __attribute__((ext_vector_type(2)));
typedef unsigned u32x4 __attribute__((ext_vector_type(4)));
typedef unsigned u32x2 __attribute__((ext_vector_type(2)));
typedef int i32x4 __attribute__((ext_vector_type(4)));

constexpr int D = 1024, NB = 8, T = 4096, NL = NB * T, CT = 256, NC = NB * CT, NT0 = NL + NC;
constexpr int NE = 32;
constexpr int NTHR = 512;
constexpr int LDS_BYTES = 147456;
constexpr int NPHASE = 19;

constexpr size_t WS_CTL   = 0;
constexpr size_t CTL_CNT  = 16384;
constexpr size_t CTL_BLK  = 32768;
constexpr size_t CTL_SP8  = 20480;
constexpr int IDTAB = 131072 + 1024, BIASTAB = 131072 + 2048;
constexpr size_t WS_MOD   = 65536;
constexpr size_t WS_WGU   = 1048576;
constexpr size_t WS_H8    = WS_WGU + 134217728;
constexpr size_t WS_WDN   = WS_WGU + 268435456;
constexpr size_t WS_WPOOL = WS_WDN + 134217728;
constexpr size_t WS_WIN   = WS_WPOOL + 524288;
constexpr size_t WS_WGATE = WS_WIN + 4194304;
constexpr size_t WS_WOUT  = WS_WGATE + 2097152;
constexpr size_t WS_H     = WS_WOUT + 2097152;
constexpr size_t WS_Z     = WS_H + 71303168;
constexpr size_t WS_LAT   = WS_Z + 71303168;
constexpr size_t WS_TKE   = WS_LAT + 142606336;
constexpr size_t WS_TKW   = WS_TKE + 557056;
constexpr size_t WS_POS   = WS_TKW + 557056;
constexpr size_t WS_LIST  = WS_POS + 557056;
constexpr size_t WS_ACT   = WS_LIST + 4456448;
constexpr size_t WS_OUTB  = WS_ACT + 301989888;
constexpr size_t WS_END   = WS_OUTB + 301989888;
constexpr size_t WS_LA    = WS_ACT;
constexpr size_t WS_BB    = WS_ACT + 142606336;
constexpr size_t WS_GATE  = WS_OUTB;
constexpr size_t WS_U     = WS_GATE + 67108864;
constexpr size_t WS_HG    = WS_U + 71303168;
constexpr size_t WS_AGL   = WS_HG + 67108864;
constexpr size_t WS_AGS   = WS_AGL + 8912896;
constexpr size_t WS_CAR   = WS_AGS + 8912896;

struct Params {
    const float* in[26];
    float* out;
    unsigned char* ws;
    int ph_lo, ph_hi;
};

__device__ __forceinline__ unsigned cvt_pk_bf16(float lo, float hi) { unsigned r; asm("v_cvt_pk_bf16_f32 %0, %1, %2" : "=v"(r) : "v"(lo), "v"(hi)); return r; }
__device__ __forceinline__ float bf_lo(unsigned u) { return __uint_as_float(u << 16); }
__device__ __forceinline__ float bf_hi(unsigned u) { return __uint_as_float(u & 0xffff0000u); }
__device__ __forceinline__ float wave_sum(float v) {
#pragma unroll
    for (int o = 1; o < 64; o <<= 1) v += __shfl_xor(v, o);
    return v;
}
__device__ __forceinline__ int my_tid() { int t = threadIdx.x; asm volatile("" : "+v"(t)); return t; }
typedef __attribute__((address_space(4))) const unsigned long long* kargp_t;
#define GAS __attribute__((address_space(1)))
__device__ __forceinline__ const float* kin(int i) { kargp_t ka = (kargp_t)__builtin_amdgcn_kernarg_segment_ptr(); asm volatile("" : "+s"(ka)); return (const float*)(const GAS float*)ka[i]; }
__device__ __forceinline__ unsigned char* launder_ptr(const void* q) { unsigned long long w = (unsigned long long)q; asm volatile("" : "+s"(w)); return (unsigned char*)(GAS unsigned char*)w; }
__device__ __forceinline__ float fast_rcp(float x) { return __builtin_amdgcn_rcpf(x); }
__device__ __forceinline__ float ex2(float x) { return __builtin_amdgcn_exp2f(x); }
__device__ __forceinline__ float sigmoidf_(float x) { return fast_rcp(1.0f + __expf(-x)); }
__device__ __forceinline__ unsigned pack4_fp8(f32x4 v) { int w = 0; w = __builtin_amdgcn_cvt_pk_fp8_f32(v[0], v[1], w, false); w = __builtin_amdgcn_cvt_pk_fp8_f32(v[2], v[3], w, true); return (unsigned)w; }
__device__ __forceinline__ u32x2 pack4(f32x4 v) { u32x2 r; r.x = cvt_pk_bf16(v[0], v[1]); r.y = cvt_pk_bf16(v[2], v[3]); return r; }
__device__ __forceinline__ f32x4 unpack4(u32x2 u) { f32x4 r; r[0] = bf_lo(u.x); r[1] = bf_hi(u.x); r[2] = bf_lo(u.y); r[3] = bf_hi(u.y); return r; }

namespace pg8 {
constexpr int BM = 256, BK = 64, HALF = 128, HTB = HALF * BK * 2, STAGE_BYTES = 8 * HTB;
__device__ __forceinline__ int lds_byte(int r, int c) { const int st = (r >> 4) * 2 + (c >> 5), rr = r & 15, cc = c & 31, ob = rr * 64 + cc * 2; return st * 1024 + (ob ^ (((ob >> 9) & 1) << 5)); }
__device__ __forceinline__ void stage_rc(int b, int& R, int& C) { const int st = b / 1024, sb = b % 1024, swz = sb ^ (((sb >> 9) & 1) << 5); R = (st >> 1) * 16 + swz / 64; C = (st & 1) * 32 + (swz % 64) / 2; }
__device__ __forceinline__ int perm32(int rho) { const int n = rho >> 4, i = rho & 15; return 8 * (i >> 2) + 4 * n + (i & 3); }

struct Unit { int pm, pn, e, aux; };
typedef int i32x8 __attribute__((ext_vector_type(8)));
typedef int i32x4v __attribute__((ext_vector_type(4)));

template <int K, bool PERM, int ABL = 0, bool F8 = false, class Prob>
__device__ __forceinline__ void gemm_phase(LAS unsigned char* lds, const char* base, const Prob& P, const int vid, const int G) {
    const int tid = my_tid(), wid = __builtin_amdgcn_readfirstlane(tid >> 6), lane = tid & 63, wr = wid >> 2, wc = wid & 3, fr = lane & 15, fq = lane >> 4;
    constexpr int nt = K / BK;
    unsigned voffB[2];
#pragma unroll
    for (int i = 0; i < 2; ++i) { int R, C; stage_rc(tid * 16 + i * 8192, R, C); const int Rb = PERM ? ((R & ~31) + perm32(R & 31)) : R; voffB[i] = (unsigned)(Rb * P.ldb + C) * 2u; }
    constexpr unsigned kstep = BK * 2;
    const unsigned hstepB = (unsigned)HALF * P.ldb * 2;
    const unsigned ldsw = (unsigned)wid * 1024u;
    const int aoff = lds_byte(wr * 64 + fr, fq * 8), boff = lds_byte(wc * 32 + fr, fq * 8);
#define PG8_SA(b, h) (((b) * 2 + (h)) * HTB)
#define PG8_SB(b, h) ((4 + (b) * 2 + (h)) * HTB)
#define PG8_STAGE_B(bufoff, sboff) do { _Pragma("unroll") for (int _i = 0; _i < 2; ++_i) \
        __builtin_amdgcn_global_load_lds((const unsigned*)(base + (size_t)(unsigned)((sboff) + voffB[_i])), (LAS unsigned*)(lds + (bufoff) + ldsw + _i * 8192), 16, 0, 0); } while (0)
#define PG8_STAGE_A(bufoff, v32, kb) do { _Pragma("unroll") for (int _i = 0; _i < 2; ++_i) \
        __builtin_amdgcn_global_load_lds((const unsigned*)(base + (size_t)(unsigned)((v32) + (kb))), (LAS unsigned*)(lds + (bufoff) + ldsw + _i * 8192), 16, 0, 0); } while (0)
#define PG8_LSTAGE_B(bufoff, sboff) do { if ((ABL & 2) == 0) PG8_STAGE_B(bufoff, sboff); } while (0)
#define PG8_LSTAGE_A(bufoff, v32, kb) do { if ((ABL & 2) == 0) PG8_STAGE_A(bufoff, v32, kb); } while (0)
#define PG8_LDA(dst, b, h) do { _Pragma("unroll") for (int m = 0; m < 4; ++m) { const i32x4v _lo = *(const LAS i32x4v*)(lds + PG8_SA(b, h) + aoff + m * 2048), _hi = *(const LAS i32x4v*)(lds + PG8_SA(b, h) + aoff + m * 2048 + 1024); dst[m] = __builtin_shufflevector(_lo, _hi, 0, 1, 2, 3, 4, 5, 6, 7); } } while (0)
#define PG8_LDB(dst, b, h) do { _Pragma("unroll") for (int n = 0; n < 2; ++n) { const i32x4v _lo = *(const LAS i32x4v*)(lds + PG8_SB(b, h) + boff + n * 2048), _hi = *(const LAS i32x4v*)(lds + PG8_SB(b, h) + boff + n * 2048 + 1024); dst[n] = __builtin_shufflevector(_lo, _hi, 0, 1, 2, 3, 4, 5, 6, 7); } } while (0)
#define PG8_MMA(ai, bj, At, Bt) do { __builtin_amdgcn_s_setprio(1); if (F8) { \
        _Pragma("unroll") for (int m = 0; m < 4; ++m) _Pragma("unroll") for (int n = 0; n < 2; ++n) \
            { if ((ABL & 1) == 0) acc[ai][bj][m][n] = __builtin_amdgcn_mfma_scale_f32_16x16x128_f8f6f4(Bt[n], At[m], acc[ai][bj][m][n], 0, 0, 0, 0x7f7f7f7f, 0, 0x7f7f7f7f); else asm volatile("" :: "v"(Bt[n]), "v"(At[m])); } \
      } else { _Pragma("unroll") for (int m = 0; m < 4; ++m) _Pragma("unroll") for (int n = 0; n < 2; ++n) { \
            const bf16x8 _a0 = (bf16x8)__builtin_shufflevector(At[m], At[m], 0, 1, 2, 3), _a1 = (bf16x8)__builtin_shufflevector(At[m], At[m], 4, 5, 6, 7); \
            const bf16x8 _b0 = (bf16x8)__builtin_shufflevector(Bt[n], Bt[n], 0, 1, 2, 3), _b1 = (bf16x8)__builtin_shufflevector(Bt[n], Bt[n], 4, 5, 6, 7); \
            if ((ABL & 1) == 0) { acc[ai][bj][m][n] = __builtin_amdgcn_mfma_f32_16x16x32_bf16(_b0, _a0, acc[ai][bj][m][n], 0, 0, 0); acc[ai][bj][m][n] = __builtin_amdgcn_mfma_f32_16x16x32_bf16(_b1, _a1, acc[ai][bj][m][n], 0, 0, 0); } \
            else asm volatile("" :: "v"(Bt[n]), "v"(At[m])); } } __builtin_amdgcn_s_setprio(0); } while (0)
#define PG8_WAIT_V(n) asm volatile("s_waitcnt vmcnt(" #n ")" ::: "memory")
#define PG8_WAIT_L(n) asm volatile("s_waitcnt lgkmcnt(" #n ")" ::: "memory")
#define PG8_BAR __builtin_amdgcn_s_barrier()
#define PG8_SCHED __builtin_amdgcn_sched_barrier(0)
    Unit cur, nxt; int ui = 0;
    if (!P.unit(vid, cur)) return;
    const int rot = P.rot(vid) & (nt - 1);
#define PG8_KB(i) ((unsigned)((rot + (i)) & (nt - 1)) * kstep)
    f32x4 acc[2][2][4][2];
#pragma unroll
    for (int a = 0; a < 2; ++a)
#pragma unroll
        for (int b = 0; b < 2; ++b)
#pragma unroll
            for (int m = 0; m < 4; ++m)
#pragma unroll
                for (int n = 0; n < 2; ++n) acc[a][b][m][n] = (f32x4){0.f, 0.f, 0.f, 0.f};
    i32x8 At[4], B0[2], B1[2];
    unsigned vA[2][2];
    P.aoff_first(cur, tid, vA);
    unsigned cB = P.bbase(cur);
    { const unsigned k0 = PG8_KB(0);
    PG8_STAGE_B(PG8_SB(0, 0), cB + k0); PG8_STAGE_B(PG8_SB(0, 1), cB + hstepB + k0); PG8_STAGE_A(PG8_SA(0, 0), vA[0][_i], k0); PG8_STAGE_A(PG8_SA(0, 1), vA[1][_i], k0); }
    if (wr == 1) PG8_BAR;
    PG8_WAIT_V(2); PG8_BAR;
    { const unsigned k1p = PG8_KB(1);
    PG8_STAGE_B(PG8_SB(1, 0), cB + k1p); PG8_STAGE_A(PG8_SA(1, 0), vA[0][_i], k1p); PG8_STAGE_B(PG8_SB(1, 1), cB + hstepB + k1p); }
    PG8_WAIT_V(6); PG8_BAR;
    for (;;) {
        const bool has_next = P.unit((ui + 1) * G + vid, nxt);
        const unsigned nB = has_next ? P.bbase(nxt) : cB;
#pragma unroll 1
        for (int t = 0; t < nt; t += 2) {
            const bool last = (t == nt - 2);
            if (t == 0) { int lane2 = lane; asm volatile("" : "+v"(lane2)); P.prefetch(cur, nxt, has_next, ui, wid, lane2, lds); }
            const unsigned k1 = PG8_KB(t + 1);
            const unsigned k2 = PG8_KB(t + 2), k3 = PG8_KB(t + 3);
            const unsigned b2 = (last ? nB : cB) + k2, b3 = (last ? nB : cB) + k3;
            PG8_LDB(B0, 0, 0); PG8_LDB(B1, 0, 1); PG8_SCHED; PG8_LDA(At, 0, 0); PG8_LSTAGE_A(PG8_SA(1, 1), vA[1][_i], k1);
            PG8_WAIT_V(8); PG8_WAIT_L(0); PG8_BAR; PG8_MMA(0, 0, At, B0); PG8_MMA(0, 1, At, B1); PG8_BAR; PG8_SCHED;
            if (last && has_next) { int tid2 = tid; asm volatile("" : "+v"(tid2)); P.aoff_next(nxt, tid2, vA, lds); }
            PG8_LDA(At, 0, 1); PG8_LSTAGE_B(PG8_SB(0, 0), b2); PG8_LSTAGE_B(PG8_SB(0, 1), b2 + hstepB); PG8_LSTAGE_A(PG8_SA(0, 0), vA[0][_i], k2);
            PG8_WAIT_V(8); PG8_WAIT_L(0); PG8_BAR; PG8_MMA(1, 0, At, B0); PG8_MMA(1, 1, At, B1); PG8_BAR; PG8_SCHED;
            PG8_LDB(B0, 1, 0); PG8_LDB(B1, 1, 1); PG8_SCHED; PG8_LDA(At, 1, 0); PG8_LSTAGE_A(PG8_SA(0, 1), vA[1][_i], k2);
            PG8_WAIT_V(8); PG8_WAIT_L(0); PG8_BAR; PG8_MMA(0, 0, At, B0); PG8_MMA(0, 1, At, B1); PG8_BAR; PG8_SCHED;
            PG8_LDA(At, 1, 1); PG8_LSTAGE_B(PG8_SB(1, 0), b3); PG8_LSTAGE_B(PG8_SB(1, 1), b3 + hstepB); PG8_LSTAGE_A(PG8_SA(1, 0), vA[0][_i], k3);
            PG8_WAIT_V(8); PG8_WAIT_L(0); PG8_BAR; PG8_MMA(1, 0, At, B0); PG8_MMA(1, 1, At, B1); PG8_BAR; PG8_SCHED;
        }
        if (wr == 0) PG8_BAR;
        if ((ABL & 64) == 0) { int fr2 = fr, fq2 = fq; asm volatile("" : "+v"(fr2), "+v"(fq2)); P.epi(acc, cur, wr, wc, fr2, fq2, lds, ui); } else { _Pragma("unroll") for (int a = 0; a < 2; ++a) _Pragma("unroll") for (int b = 0; b < 2; ++b) _Pragma("unroll") for (int m = 0; m < 4; ++m) _Pragma("unroll") for (int n = 0; n < 2; ++n) asm volatile("" :: "v"(acc[a][b][m][n])); }
        if (!has_next) break;
#pragma unroll
        for (int a = 0; a < 2; ++a)
#pragma unroll
            for (int b = 0; b < 2; ++b)
#pragma unroll
                for (int m = 0; m < 4; ++m)
#pragma unroll
                    for (int n = 0; n < 2; ++n) acc[a][b][m][n] = (f32x4){0.f, 0.f, 0.f, 0.f};
        cur = nxt; cB = nB; ++ui;
        if (wr == 1) PG8_BAR;
    }
    PG8_WAIT_V(0);
    PG8_BAR;
#undef PG8_KB
#undef PG8_SA
#undef PG8_SB
#undef PG8_STAGE_A
#undef PG8_STAGE_B
#undef PG8_LSTAGE_A
#undef PG8_LSTAGE_B
#undef PG8_LDA
#undef PG8_LDB
#undef PG8_MMA
#undef PG8_WAIT_V
#undef PG8_WAIT_L
#undef PG8_BAR
#undef PG8_SCHED
}
}
using pg8::Unit;
typedef f32x4 AccT[2][2][4][2];

struct ProbPool {
    unsigned A; int ldb; unsigned Bt; bf16_t* Z;
    __device__ __forceinline__ int rot(int v) const { return v >> 2; }
    __device__ __forceinline__ bool unit(int L, Unit& u) const { if (L >= 136 * 4) return false; u.pm = L >> 2; u.pn = L & 3; u.e = 0; u.aux = 0; return true; }
    __device__ __forceinline__ void aoff_next(const Unit& u, const int tid, unsigned (&v)[2][2], LAS unsigned char*) const { aoff_first(u, tid, v); }
    __device__ __forceinline__ void prefetch(const Unit&, const Unit&, bool, int, int, int, LAS unsigned char*) const {}
    __device__ __forceinline__ void aoff_first(const Unit& u, const int tid, unsigned (&v)[2][2]) const {
        int Ra[2], Ca[2]; pg8::stage_rc(tid * 16, Ra[0], Ca[0]); pg8::stage_rc(tid * 16 + 8192, Ra[1], Ca[1]);
#pragma unroll
        for (int h = 0; h < 2; ++h)
#pragma unroll
            for (int i = 0; i < 2; ++i) v[h][i] = A + (unsigned)((u.pm * 256 + h * 128 + Ra[i]) * 1024 + u.pn * 256 + Ca[i]) * 2u;
    }
    __device__ __forceinline__ unsigned bbase(const Unit& u) const { return Bt + (unsigned)u.pn * (256u * 256u * 2u); }
    __device__ __forceinline__ void epi(const AccT& acc, const Unit& u, int wr, int wc, int fr, int fq, LAS unsigned char* lds, int ui) const {
#pragma unroll
        for (int ai = 0; ai < 2; ++ai)
#pragma unroll
            for (int m = 0; m < 4; ++m) {
                const int row = u.pm * 256 + ai * 128 + wr * 64 + m * 16 + fr;
                bf16_t* rp = Z + (size_t)row * 1024 + u.pn * 256 + wc * 32 + fq * 8;
#pragma unroll
                for (int bj = 0; bj < 2; ++bj) { const f32x4 v0 = acc[ai][bj][m][0], v1 = acc[ai][bj][m][1];
                    u32x4 w; w.x = cvt_pk_bf16(v0[0], v0[1]); w.y = cvt_pk_bf16(v0[2], v0[3]); w.z = cvt_pk_bf16(v1[0], v1[1]); w.w = cvt_pk_bf16(v1[2], v1[3]);
                    *(u32x4*)(rp + bj * 128) = w; }
            }
    }
};

__device__ __forceinline__ void moe_table(LAS int* tab, const int* counts) {
    const int tid = my_tid();
    if (tid < 32) tab[40 + tid] = counts[tid];
    __syncthreads();
    if (tid < 33) { int s = 0; for (int e = 0; e < tid; ++e) s += (tab[40 + e] + 255) >> 8; tab[tid] = s; }
    __syncthreads();
}

struct ProbMoe1 {
    unsigned A; int ldb; unsigned Bt; LAS const int* tab; const int* list; const float* bgu; bf16_t* ACT;
    __device__ __forceinline__ int rot(int v) const { return 0; }
    __device__ __forceinline__ bool unit(int L, Unit& u) const {
        const int mt = L >> 3; if (mt >= tab[32]) return false;
        int e = 0; while (tab[e + 1] <= mt) ++e;
        e = __builtin_amdgcn_readfirstlane(e);
        u.e = e; u.pn = L & 7; u.pm = __builtin_amdgcn_readfirstlane(mt - tab[e]); u.aux = __builtin_amdgcn_readfirstlane(mt * 256); return true;
    }
    __device__ __forceinline__ void aoff_first(const Unit& u, const int tid, unsigned (&v)[2][2]) const {
        int Ra[2], Ca[2]; pg8::stage_rc(tid * 16, Ra[0], Ca[0]); pg8::stage_rc(tid * 16 + 8192, Ra[1], Ca[1]);
        const int cnt = tab[40 + u.e];
#pragma unroll
        for (int h = 0; h < 2; ++h)
#pragma unroll
            for (int i = 0; i < 2; ++i) { const int r = u.pm * 256 + h * 128 + Ra[i]; const int tok = list[u.e * NT0 + min(r, cnt - 1)]; v[h][i] = A + (unsigned)tok * 1024u + (unsigned)Ca[i] * 2u; }
    }
    __device__ __forceinline__ void aoff_next(const Unit& u, const int tid, unsigned (&v)[2][2], LAS unsigned char* lds) const {
        int Ra[2], Ca[2]; pg8::stage_rc(tid * 16, Ra[0], Ca[0]); pg8::stage_rc(tid * 16 + 8192, Ra[1], Ca[1]);
        const LAS int* idt = (const LAS int*)(lds + IDTAB);
#pragma unroll
        for (int h = 0; h < 2; ++h)
#pragma unroll
            for (int i = 0; i < 2; ++i) { const int tok = idt[h * 128 + Ra[i]]; v[h][i] = A + (unsigned)tok * 1024u + (unsigned)Ca[i] * 2u; }
    }
    __device__ __forceinline__ void prefetch(const Unit& cur, const Unit& nxt, bool has_next, int ui, int wid, int lane, LAS unsigned char* lds) const {
        if (wid < 4) {
            if (has_next) { const int cnt = tab[40 + nxt.e]; const int r = nxt.pm * 256 + wid * 64 + lane;
                __builtin_amdgcn_global_load_lds((const unsigned*)(list + (size_t)nxt.e * NT0 + min(r, cnt - 1)), (LAS unsigned*)(lds + IDTAB + wid * 256), 4, 0, 0); }
        } else { const int w = wid - 4;
            __builtin_amdgcn_global_load_lds((const unsigned*)(bgu + (size_t)cur.e * 2048 + (w >> 1) * 1024 + cur.pn * 128 + (w & 1) * 64 + lane), (LAS unsigned*)(lds + BIASTAB + (ui & 1) * 1024 + w * 256), 4, 0, 0); }
    }
    __device__ __forceinline__ unsigned bbase(const Unit& u) const { return Bt + ((unsigned)u.e * 2048u + (unsigned)u.pn * 256u) * 1024u; }
    __device__ __forceinline__ void epi(const AccT& acc, const Unit& u, int wr, int wc, int fr, int fq, LAS unsigned char* lds, int ui) const {
        const int j0 = u.pn * 128 + wc * 32 + fq * 8;
        const LAS float* bg = (const LAS float*)(lds + BIASTAB + (ui & 1) * 1024) + wc * 32 + fq * 8;
        const f32x4 bg0 = *(const LAS f32x4*)(bg), bg1 = *(const LAS f32x4*)(bg + 4), bu0 = *(const LAS f32x4*)(bg + 128), bu1 = *(const LAS f32x4*)(bg + 132);
#pragma unroll
        for (int ai = 0; ai < 2; ++ai)
#pragma unroll
            for (int m = 0; m < 4; ++m) {
                const int slot = u.aux + ai * 128 + wr * 64 + m * 16 + fr;
                const f32x4 g0 = acc[ai][0][m][0] * 0.015625f + bg0, g1 = acc[ai][0][m][1] * 0.015625f + bg1, u0 = acc[ai][1][m][0] * 0.015625f + bu0, u1 = acc[ai][1][m][1] * 0.015625f + bu1;
                float o[8];
#pragma unroll
                for (int c = 0; c < 4; ++c) {
                    float g = fminf(g0[c], 7.0f), uu = fminf(fmaxf(u0[c], -7.0f), 7.0f); o[c] = (uu + 1.0f) * g * sigmoidf_(1.702f * g);
                    g = fminf(g1[c], 7.0f); uu = fminf(fmaxf(u1[c], -7.0f), 7.0f); o[4 + c] = (uu + 1.0f) * g * sigmoidf_(1.702f * g);
                }
                u32x2 w; w.x = pack4_fp8((f32x4){o[0], o[1], o[2], o[3]}); w.y = pack4_fp8((f32x4){o[4], o[5], o[6], o[7]});
                *(u32x2*)((unsigned char*)ACT + (size_t)slot * 1024 + j0) = w;
            }
    }
};

struct ProbMoe2 {
    unsigned A; int ldb; unsigned Bt; LAS const int* tab; const float* bdn; bf16_t* OUTB;
    __device__ __forceinline__ int rot(int v) const { return 0; }
    __device__ __forceinline__ bool unit(int L, Unit& u) const {
        const int mt = L >> 2; if (mt >= tab[32]) return false;
        int e = 0; while (tab[e + 1] <= mt) ++e;
        e = __builtin_amdgcn_readfirstlane(e);
        u.e = e; u.pn = L & 3; u.pm = 0; u.aux = __builtin_amdgcn_readfirstlane(mt * 256); return true;
    }
    __device__ __forceinline__ void aoff_first(const Unit& u, const int tid, unsigned (&v)[2][2]) const {
        int Ra[2], Ca[2]; pg8::stage_rc(tid * 16, Ra[0], Ca[0]); pg8::stage_rc(tid * 16 + 8192, Ra[1], Ca[1]);
#pragma unroll
        for (int h = 0; h < 2; ++h)
#pragma unroll
            for (int i = 0; i < 2; ++i) v[h][i] = A + (unsigned)(u.aux + h * 128 + Ra[i]) * 1024u + (unsigned)Ca[i] * 2u;
    }
    __device__ __forceinline__ void aoff_next(const Unit& u, const int tid, unsigned (&v)[2][2], LAS unsigned char*) const { aoff_first(u, tid, v); }
    __device__ __forceinline__ void prefetch(const Unit& cur, const Unit&, bool, int ui, int wid, int lane, LAS unsigned char* lds) const {
        if (wid >= 4) { const int w = wid - 4;
            __builtin_amdgcn_global_load_lds((const unsigned*)(bdn + (size_t)cur.e * 1024 + cur.pn * 256 + w * 64 + lane), (LAS unsigned*)(lds + BIASTAB + (ui & 1) * 1024 + w * 256), 4, 0, 0); }
    }
    __device__ __forceinline__ unsigned bbase(const Unit& u) const { return Bt + ((unsigned)u.e * 1024u + (unsigned)u.pn * 256u) * 1024u; }
    __device__ __forceinline__ void epi(const AccT& acc, const Unit& u, int wr, int wc, int fr, int fq, LAS unsigned char* lds, int ui) const {
        const int c0 = u.pn * 256 + wc * 32 + fq * 8;
        const LAS float* bp = (const LAS float*)(lds + BIASTAB + (ui & 1) * 1024) + wc * 32 + fq * 8;
        f32x4 bv[2][2];
#pragma unroll
        for (int bj = 0; bj < 2; ++bj) { bv[bj][0] = *(const LAS f32x4*)(bp + bj * 128); bv[bj][1] = *(const LAS f32x4*)(bp + bj * 128 + 4); }
#pragma unroll
        for (int ai = 0; ai < 2; ++ai)
#pragma unroll
            for (int m = 0; m < 4; ++m) {
                const int slot = u.aux + ai * 128 + wr * 64 + m * 16 + fr;
                bf16_t* rp = OUTB + (size_t)slot * 1024 + c0;
#pragma unroll
                for (int bj = 0; bj < 2; ++bj) { const f32x4 v0 = acc[ai][bj][m][0] * 0.015625f + bv[bj][0], v1 = acc[ai][bj][m][1] * 0.015625f + bv[bj][1];
                    u32x4 w; w.x = cvt_pk_bf16(v0[0], v0[1]); w.y = cvt_pk_bf16(v0[2], v0[3]); w.z = cvt_pk_bf16(v1[0], v1[1]); w.w = cvt_pk_bf16(v1[2], v1[3]);
                    *(u32x4*)(rp + bj * 128) = w; }
            }
    }
};

struct ProbIn {
    unsigned A; int ldb; unsigned Bt; bf16_t* GATE; bf16_t* UPRE;
    __device__ __forceinline__ int rot(int v) const { return 0; }
    __device__ __forceinline__ bool unit(int L, Unit& u) const {
        if (L < 1024) { u.pm = L >> 3; u.pn = L & 7; } else { const int q = L - 1024; if (q >= 32) return false; u.pm = 128 + (q >> 2); u.pn = 4 + (q & 3); }
        u.e = 0; u.aux = 0; return true;
    }
    __device__ __forceinline__ void aoff_next(const Unit& u, const int tid, unsigned (&v)[2][2], LAS unsigned char*) const { aoff_first(u, tid, v); }
    __device__ __forceinline__ void prefetch(const Unit&, const Unit&, bool, int, int, int, LAS unsigned char*) const {}
    __device__ __forceinline__ void aoff_first(const Unit& u, const int tid, unsigned (&v)[2][2]) const {
        int Ra[2], Ca[2]; pg8::stage_rc(tid * 16, Ra[0], Ca[0]); pg8::stage_rc(tid * 16 + 8192, Ra[1], Ca[1]);
#pragma unroll
        for (int h = 0; h < 2; ++h)
#pragma unroll
            for (int i = 0; i < 2; ++i) v[h][i] = A + (unsigned)((u.pm * 256 + h * 128 + Ra[i]) * 1024 + Ca[i]) * 2u;
    }
    __device__ __forceinline__ unsigned bbase(const Unit& u) const { return Bt + (unsigned)u.pn * (256u * 1024u * 2u); }
    __device__ __forceinline__ void epi(const AccT& acc, const Unit& u, int wr, int wc, int fr, int fq, LAS unsigned char* lds, int ui) const {
        const bool isg = u.pn < 4;
        bf16_t* base = isg ? GATE : UPRE; const int c0 = (u.pn & 3) * 256 + wc * 32 + fq * 8;
#pragma unroll
        for (int ai = 0; ai < 2; ++ai)
#pragma unroll
            for (int m = 0; m < 4; ++m) {
                const int row = u.pm * 256 + ai * 128 + wr * 64 + m * 16 + fr;
                bf16_t* rp = base + (size_t)row * 1024 + c0;
#pragma unroll
                for (int bj = 0; bj < 2; ++bj) { f32x4 v0 = acc[ai][bj][m][0], v1 = acc[ai][bj][m][1];
                    if (isg) {
#pragma unroll
                        for (int c = 0; c < 4; ++c) { float x = v0[c]; v0[c] = x * sigmoidf_(1.5957691216f * (x + 0.044715f * x * x * x)); x = v1[c]; v1[c] = x * sigmoidf_(1.5957691216f * (x + 0.044715f * x * x * x)); }
                    }
                    u32x4 w; w.x = cvt_pk_bf16(v0[0], v0[1]); w.y = cvt_pk_bf16(v0[2], v0[3]); w.z = cvt_pk_bf16(v1[0], v1[1]); w.w = cvt_pk_bf16(v1[2], v1[3]);
                    *(u32x4*)(rp + bj * 128) = w; }
            }
    }
};

struct ProbGate {
    unsigned A; int ldb; unsigned Bt; const bf16_t* U; const float* br; const float* bi; const float* lam; bf16_t* LA; bf16_t* BBp;
    __device__ __forceinline__ int rot(int v) const { return v; }
    __device__ __forceinline__ bool unit(int L, Unit& u) const { if (L >= 136 * 16) return false; u.pm = L >> 4; u.e = (L >> 2) & 3; u.pn = L & 3; u.aux = 0; return true; }
    __device__ __forceinline__ void aoff_next(const Unit& u, const int tid, unsigned (&v)[2][2], LAS unsigned char*) const { aoff_first(u, tid, v); }
    __device__ __forceinline__ void prefetch(const Unit&, const Unit&, bool, int, int, int, LAS unsigned char*) const {}
    __device__ __forceinline__ void aoff_first(const Unit& u, const int tid, unsigned (&v)[2][2]) const {
        int Ra[2], Ca[2]; pg8::stage_rc(tid * 16, Ra[0], Ca[0]); pg8::stage_rc(tid * 16 + 8192, Ra[1], Ca[1]);
#pragma unroll
        for (int h = 0; h < 2; ++h)
#pragma unroll
            for (int i = 0; i < 2; ++i) v[h][i] = A + (unsigned)((u.pm * 256 + h * 128 + Ra[i]) * 1024 + u.e * 256 + Ca[i]) * 2u;
    }
    __device__ __forceinline__ unsigned bbase(const Unit& u) const { return Bt + ((unsigned)u.e * 1024u + (unsigned)u.pn * 256u) * 512u; }
    __device__ __forceinline__ void epi(const AccT& acc, const Unit& u, int wr, int wc, int fr, int fq, LAS unsigned char* lds, int ui) const {
        const int d = u.pn >> 1, ch0 = u.e * 256 + (u.pn & 1) * 128 + wc * 32 + fq * 8;
        f32x4 brv[2], biv[2], sp[2];
#pragma unroll
        for (int n = 0; n < 2; ++n) { brv[n] = *(const f32x4*)(br + d * 1024 + ch0 + 4 * n); biv[n] = *(const f32x4*)(bi + d * 1024 + ch0 + 4 * n); sp[n] = *(const f32x4*)(lam + d * 1024 + ch0 + 4 * n); }
#pragma unroll
        for (int ai = 0; ai < 2; ++ai) {
            u32x4 uraw[4];
#pragma unroll
            for (int m = 0; m < 4; ++m) uraw[m] = *(const u32x4*)(U + (size_t)(u.pm * 256 + ai * 128 + wr * 64 + m * 16 + fr) * 1024 + ch0);
#pragma unroll
            for (int m = 0; m < 4; ++m) {
                const int row = u.pm * 256 + ai * 128 + wr * 64 + m * 16 + fr;
                const u32x4 ur = uraw[m];
                const f32x4 uu[2] = {(f32x4){bf_lo(ur.x), bf_hi(ur.x), bf_lo(ur.y), bf_hi(ur.y)}, (f32x4){bf_lo(ur.z), bf_hi(ur.z), bf_lo(ur.w), bf_hi(ur.w)}};
                float la[8], bb[8];
#pragma unroll
                for (int n = 0; n < 2; ++n) {
                    const f32x4 pr = acc[ai][0][m][n] + brv[n], pi = acc[ai][1][m][n] + biv[n];
#pragma unroll
                    for (int c = 0; c < 4; ++c) { const float r = fast_rcp(1.0f + ex2(-1.44269504089f * pr[c])), ig = fast_rcp(1.0f + ex2(-1.44269504089f * pi[c])); const float l2 = -r * sp[n][c]; la[4 * n + c] = l2;
                        const float a2 = ex2(2.0f * l2); bb[4 * n + c] = __builtin_amdgcn_sqrtf(fmaxf(1.0f - a2, 0.0f)) * (ig * uu[n][c]); }
                }
                u32x4 w; w.x = cvt_pk_bf16(la[0], la[1]); w.y = cvt_pk_bf16(la[2], la[3]); w.z = cvt_pk_bf16(la[4], la[5]); w.w = cvt_pk_bf16(la[6], la[7]);
                *(u32x4*)(LA + ((size_t)d * NT0 + row) * 1024 + ch0) = w;
                w.x = cvt_pk_bf16(bb[0], bb[1]); w.y = cvt_pk_bf16(bb[2], bb[3]); w.z = cvt_pk_bf16(bb[4], bb[5]); w.w = cvt_pk_bf16(bb[6], bb[7]);
                *(u32x4*)(BBp + ((size_t)d * NT0 + row) * 1024 + ch0) = w;
            }
            asm volatile("" ::: "memory");
        }
    }
};

struct ProbOut {
    unsigned A; int ldb; unsigned Bt; const float* g1; float* LAT;
    __device__ __forceinline__ int rot(int v) const { return 0; }
    __device__ __forceinline__ bool unit(int L, Unit& u) const { if (L >= 128 * 4) return false; u.pm = L >> 2; u.pn = L & 3; u.e = 0; u.aux = 0; return true; }
    __device__ __forceinline__ void aoff_next(const Unit& u, const int tid, unsigned (&v)[2][2], LAS unsigned char*) const { aoff_first(u, tid, v); }
    __device__ __forceinline__ void prefetch(const Unit&, const Unit&, bool, int, int, int, LAS unsigned char*) const {}
    __device__ __forceinline__ void aoff_first(const Unit& u, const int tid, unsigned (&v)[2][2]) const {
        int Ra[2], Ca[2]; pg8::stage_rc(tid * 16, Ra[0], Ca[0]); pg8::stage_rc(tid * 16 + 8192, Ra[1], Ca[1]);
#pragma unroll
        for (int h = 0; h < 2; ++h)
#pragma unroll
            for (int i = 0; i < 2; ++i) v[h][i] = A + (unsigned)((u.pm * 256 + h * 128 + Ra[i]) * 1024 + Ca[i]) * 2u;
    }
    __device__ __forceinline__ unsigned bbase(const Unit& u) const { return Bt + (unsigned)u.pn * (256u * 1024u * 2u); }
    __device__ __forceinline__ void epi(const AccT& acc, const Unit& u, int wr, int wc, int fr, int fq, LAS unsigned char* lds, int ui) const {
        const int b = u.pm >> 4; const int c0 = u.pn * 256 + wc * 32 + fq * 4;
        f32x4 gv[2][2];
#pragma unroll
        for (int bj = 0; bj < 2; ++bj)
#pragma unroll
            for (int n = 0; n < 2; ++n) gv[bj][n] = *(const f32x4*)(g1 + (size_t)b * 6144 + c0 + bj * 128 + n * 16);
#pragma unroll
        for (int ai = 0; ai < 2; ++ai)
#pragma unroll
            for (int mp = 0; mp < 2; ++mp) {
                f32x4 old[2][2][2];
#pragma unroll
                for (int mm = 0; mm < 2; ++mm) { const int row = u.pm * 256 + ai * 128 + wr * 64 + (2 * mp + mm) * 16 + fr; const float* rp = LAT + (size_t)row * 1024 + c0;
#pragma unroll
                    for (int bj = 0; bj < 2; ++bj)
#pragma unroll
                        for (int n = 0; n < 2; ++n) old[mm][bj][n] = *(const f32x4*)(rp + bj * 128 + n * 16); }
#pragma unroll
                for (int mm = 0; mm < 2; ++mm) { const int row = u.pm * 256 + ai * 128 + wr * 64 + (2 * mp + mm) * 16 + fr; float* rp = LAT + (size_t)row * 1024 + c0;
#pragma unroll
                    for (int bj = 0; bj < 2; ++bj)
#pragma unroll
                        for (int n = 0; n < 2; ++n) *(f32x4*)(rp + bj * 128 + n * 16) = old[mm][bj][n] + gv[bj][n] * acc[ai][bj][2 * mp + mm][n]; }
                asm volatile("" ::: "memory");
            }
    }
};

__device__ __forceinline__ void tr_item(const float* src, int ldw, int k0, int n0, bf16_t* dst, int ldd, int mapkind, int mp_d, int mp_ri, LAS float* scr, int lane) {
#pragma unroll 4
    for (int i = 0; i < 16; ++i) { const int kk = 4 * i + (lane >> 4); const f32x4 v = *(const f32x4*)(src + (size_t)(k0 + kk) * ldw + n0 + 4 * (lane & 15));
        LAS float* s = scr + kk * 65 + 4 * (lane & 15); s[0] = v[0]; s[1] = v[1]; s[2] = v[2]; s[3] = v[3]; }
    asm volatile("s_waitcnt lgkmcnt(0)" ::: "memory");
    const int c = lane & 7;
#pragma unroll
    for (int j = 0; j < 8; ++j) { const int nl = (lane >> 3) + 8 * j; const int n = n0 + nl; const LAS float* s = scr + (8 * c) * 65 + nl;
        u32x4 o; o.x = cvt_pk_bf16(s[0], s[65]); o.y = cvt_pk_bf16(s[2 * 65], s[3 * 65]); o.z = cvt_pk_bf16(s[4 * 65], s[5 * 65]); o.w = cvt_pk_bf16(s[6 * 65], s[7 * 65]);
        int row;
        if (mapkind == 0) row = n;
        else if (mapkind == 1) { const int jj = n & 1023; row = (jj >> 7) * 256 + (n >> 10) * 128 + (jj & 127); }
        else row = ((mp_d * 2 + (n >> 7)) * 2 + mp_ri) * 128 + (n & 127);
        *(u32x4*)(dst + (size_t)row * ldd + k0 + 8 * c) = o; }
    asm volatile("s_waitcnt lgkmcnt(0)" ::: "memory");
}

__device__ __forceinline__ void tr_item8(const float* src, int ldw, int k0, int n0, unsigned char* dst, int ldd, int mapkind, LAS float* scr, int lane) {
#pragma unroll 4
    for (int i = 0; i < 16; ++i) { const int kk = 4 * i + (lane >> 4); const f32x4 v = *(const f32x4*)(src + (size_t)(k0 + kk) * ldw + n0 + 4 * (lane & 15));
        LAS float* s = scr + kk * 65 + 4 * (lane & 15); s[0] = v[0]; s[1] = v[1]; s[2] = v[2]; s[3] = v[3]; }
    asm volatile("s_waitcnt lgkmcnt(0)" ::: "memory");
    const int c = lane & 3;
#pragma unroll
    for (int j = 0; j < 4; ++j) { const int nl = (lane >> 2) + 16 * j; const int n = n0 + nl; const LAS float* s = scr + (16 * c) * 65 + nl;
        u32x4 o;
        o.x = pack4_fp8((f32x4){s[0], s[65], s[2 * 65], s[3 * 65]} * 64.0f); o.y = pack4_fp8((f32x4){s[4 * 65], s[5 * 65], s[6 * 65], s[7 * 65]} * 64.0f);
        o.z = pack4_fp8((f32x4){s[8 * 65], s[9 * 65], s[10 * 65], s[11 * 65]} * 64.0f); o.w = pack4_fp8((f32x4){s[12 * 65], s[13 * 65], s[14 * 65], s[15 * 65]} * 64.0f);
        const int jj = n & 1023; const int row = mapkind ? ((jj >> 7) * 256 + (n >> 10) * 128 + (jj & 127)) : n;
        *(u32x4*)(dst + (size_t)row * ldd + k0 + 16 * c) = o; }
    asm volatile("s_waitcnt lgkmcnt(0)" ::: "memory");
}

__device__ __forceinline__ void phase_prep(const Params& p, LAS unsigned char* lds, int bid, int G) {
    unsigned char* const ws = launder_ptr(p.ws);
    const int tid = my_tid(), lane = tid & 63, wave = tid >> 6;
    const float* cvec = kin(1); const float* cctx = kin(3); const float* adaw = kin(4); const float* adab = kin(5);
    for (int item = bid; item < 192; item += G) {
        LAS float* sc = (LAS float*)lds; LAS float* red = (LAS float*)(lds + 36864);
        for (int i = tid; i < 9 * 1024; i += NTHR) { const float v = i < 8192 ? cvec[i] : cctx[i - 8192]; sc[i] = v * fast_rcp(1.0f + __expf(-v)); }
        __syncthreads();
        const int l = item / 96, n0 = (item % 96) * 64, kq = tid >> 4, cq = tid & 15;
        f32x4 acc[9];
#pragma unroll
        for (int b = 0; b < 9; ++b) acc[b] = (f32x4){0.f, 0.f, 0.f, 0.f};
        const float* W = adaw + (size_t)l * 1024 * 6144 + n0 + 4 * cq;
#pragma unroll 4
        for (int kk = 0; kk < 32; ++kk) { const int k = kq + 32 * kk; const f32x4 w = *(const f32x4*)(W + (size_t)k * 6144);
#pragma unroll
            for (int b = 0; b < 9; ++b) acc[b] += sc[b * 1024 + k] * w; }
#pragma unroll
        for (int b = 0; b < 9; ++b)
#pragma unroll
            for (int c = 0; c < 4; ++c) { float v = acc[b][c]; v += __shfl_xor(v, 16); v += __shfl_xor(v, 32); acc[b][c] = v; }
        if (lane < 16) {
#pragma unroll
            for (int b = 0; b < 9; ++b) *(LAS f32x4*)(red + (wave * 9 + b) * 64 + 4 * cq) = acc[b]; }
        __syncthreads();
        for (int o = tid; o < 576; o += NTHR) { const int b = o >> 6, c = o & 63; float s = 0.f;
#pragma unroll
            for (int w = 0; w < 8; ++w) s += red[(w * 9 + b) * 64 + c];
            ((float*)(ws + WS_MOD))[(size_t)(l * 9 + b) * 6144 + n0 + c] = s + adab[l * 6144 + n0 + c]; }
        __syncthreads();
    }
    if (bid == G - 1) { const float* lamp = kin(17); for (int i = tid; i < 2048; i += NTHR) ((float*)(ws + WS_CTL + CTL_SP8))[i] = 8.0f * 1.44269504089f * log1pf(__expf(-lamp[i])); }
    LAS float* scr = (LAS float*)(lds + wave * 16640);
    constexpr int NITEMS = 32768 + 16384 + 64 + 512 + 256 + 256;
    for (int it = bid * 8 + wave; it < NITEMS; it += G * 8) {
        int r = it;
        if (r < 32768) { const int le = r >> 9, q = r & 511; tr_item8(kin(21) + (size_t)le * 1024 * 2048, 2048, (q >> 5) * 64, (q & 31) * 64, ws + WS_WGU + (size_t)le * 2048 * 1024, 1024, 1, scr, lane); continue; }
        r -= 32768;
        if (r < 16384) { const int le = r >> 8, q = r & 255; tr_item8(kin(23) + (size_t)le * 1024 * 1024, 1024, (q >> 4) * 64, (q & 15) * 64, ws + WS_WDN + (size_t)le * 1024 * 1024, 1024, 0, scr, lane); continue; }
        r -= 16384;
        if (r < 64) { const int g = r >> 4, q = r & 15; tr_item(kin(8) + (size_t)g * 65536, 256, (q >> 2) * 64, (q & 3) * 64, (bf16_t*)(ws + WS_WPOOL) + (size_t)g * 65536, 256, 0, 0, 0, scr, lane); continue; }
        r -= 64;
        if (r < 512) { tr_item(kin(10), 2048, (r >> 5) * 64, (r & 31) * 64, (bf16_t*)(ws + WS_WIN), 1024, 0, 0, 0, scr, lane); continue; }
        r -= 512;
        if (r < 256) { const int m16 = r >> 4, q = r & 15, ri = m16 >> 3, d = (m16 >> 2) & 1, head = m16 & 3;
            tr_item((ri ? kin(15) : kin(13)) + (size_t)(d * 4 + head) * 65536, 256, (q >> 2) * 64, (q & 3) * 64, (bf16_t*)(ws + WS_WGATE) + (size_t)head * 1024 * 256, 256, 2, d, ri, scr, lane); continue; }
        r -= 256;
        tr_item(kin(18), 1024, (r >> 4) * 64, (r & 15) * 64, (bf16_t*)(ws + WS_WOUT), 1024, 0, 0, 0, scr, lane);
    }
}

__device__ __forceinline__ void phase_norm0(const Params& p, int bid, int G) {
    unsigned char* const ws = launder_ptr(p.ws);
    const int tid = my_tid(), lane = tid & 63, wave = tid >> 6;
    const float* mod = (const float*)(ws + WS_MOD);
    bf16_t* H = (bf16_t*)(ws + WS_H);
    const float* xin = kin(0); const float* cin = kin(2); const float* gain0 = kin(6);
    for (int tok = bid * 8 + wave; tok < NT0; tok += G * 8) {
        const float* src = tok < NL ? xin + (size_t)tok * 1024 : cin + (size_t)(tok - NL) * 1024;
        const int bi = tok < NL ? (tok >> 12) : 8;
        f32x4 v[4]; float ss = 0.f;
#pragma unroll
        for (int j = 0; j < 4; ++j) { v[j] = *(const f32x4*)(src + 256 * j + 4 * lane); ss += v[j][0] * v[j][0] + v[j][1] * v[j][1] + v[j][2] * v[j][2] + v[j][3] * v[j][3]; }
        const float rstd = rsqrtf(wave_sum(ss) * (1.0f / 1024.0f) + 1e-6f);
        const float* mb = mod + (size_t)bi * 6144;
#pragma unroll
        for (int j = 0; j < 4; ++j) { const int ch = 256 * j + 4 * lane;
            const f32x4 gn = *(const f32x4*)(gain0 + ch), sh = *(const f32x4*)(mb + ch), sc = *(const f32x4*)(mb + 1024 + ch);
            const f32x4 h = v[j] * rstd * gn * (1.0f + sc) + sh;
            *(u32x2*)(H + (size_t)tok * 1024 + ch) = pack4(h); }
    }
}

__device__ __forceinline__ void phase_pool(const Params& p, LAS unsigned char* lds, int bid, int G) {
    unsigned char* const ws = launder_ptr(p.ws);
    const int tid = my_tid(), tk = tid >> 3, sub = tid & 7;
    const bf16_t* Z = (const bf16_t*)(ws + WS_Z);
    float* LAT = (float*)(ws + WS_LAT);
    const float* mod = (const float*)(ws + WS_MOD);
    LAS float* Vs = (LAS float*)lds;
    const float* xin = kin(0); const float* cin = kin(2); const float* pscale = kin(9);
    for (int item = bid; item < 2048 + 128; item += G) {
        if (item < 2048) {
            const int b = item >> 8, r = (item >> 2) & 63, g = (item + item / G) & 3, hw = 1 << g;
            const int r0 = max(r - hw, 0), r1 = min(r + hw, 64);
            const int chb = g * 256 + sub * 8;
            f32x4 V[4][2]; u32x4 zc[4]; f32x4 xv[4][2];
            { const size_t rowx = (size_t)b * 4096 + r * 64 + tk;
#pragma unroll
              for (int j = 0; j < 4; ++j) { xv[j][0] = *(const f32x4*)(xin + rowx * 1024 + chb + 64 * j); xv[j][1] = *(const f32x4*)(xin + rowx * 1024 + chb + 64 * j + 4); } }
#pragma unroll
            for (int j = 0; j < 4; ++j) { V[j][0] = (f32x4){0.f, 0.f, 0.f, 0.f}; V[j][1] = (f32x4){0.f, 0.f, 0.f, 0.f}; zc[j] = (u32x4){0u, 0u, 0u, 0u}; }
            for (int rr = r0; rr < r1; rr += 4) {
                u32x4 w4[4][4];
#pragma unroll
                for (int q = 0; q < 4; ++q) { const bf16_t* zp = Z + ((size_t)(b * 4096 + (rr + q) * 64 + tk)) * 1024 + chb;
#pragma unroll
                    for (int j = 0; j < 4; ++j) w4[q][j] = (rr + q < r1) ? *(const u32x4*)(zp + 64 * j) : (u32x4){0u, 0u, 0u, 0u}; }
#pragma unroll
                for (int q = 0; q < 4; ++q)
#pragma unroll
                    for (int j = 0; j < 4; ++j) { const u32x4 w = w4[q][j];
                        V[j][0] += (f32x4){bf_lo(w.x), bf_hi(w.x), bf_lo(w.y), bf_hi(w.y)}; V[j][1] += (f32x4){bf_lo(w.z), bf_hi(w.z), bf_lo(w.w), bf_hi(w.w)};
                        if (rr + q == r) zc[j] = w; }
            }
#pragma unroll
            for (int j = 0; j < 4; ++j) { *(LAS f32x4*)(Vs + tk * 260 + sub * 8 + 64 * j) = V[j][0]; *(LAS f32x4*)(Vs + tk * 260 + sub * 8 + 64 * j + 4) = V[j][1]; }
            __syncthreads();
            const int c0 = max(tk - hw, 0), c1 = min(tk + hw, 64);
            f32x4 Hs[4][2];
#pragma unroll
            for (int j = 0; j < 4; ++j) { Hs[j][0] = (f32x4){0.f, 0.f, 0.f, 0.f}; Hs[j][1] = (f32x4){0.f, 0.f, 0.f, 0.f}; }
            for (int cc = c0; cc < c1; ++cc) {
#pragma unroll
                for (int j = 0; j < 4; ++j) { Hs[j][0] += *(const LAS f32x4*)(Vs + cc * 260 + sub * 8 + 64 * j); Hs[j][1] += *(const LAS f32x4*)(Vs + cc * 260 + sub * 8 + 64 * j + 4); }
            }
            const float inv = 1.0f / (float)((r1 - r0) * (c1 - c0));
            const size_t row = (size_t)b * 4096 + r * 64 + tk;
            const float* g1 = mod + (size_t)b * 6144 + 2048;
            f32x4 pv4[4][2], gv4[4][2];
#pragma unroll
            for (int j = 0; j < 4; ++j) { const int ch = chb + 64 * j;
                pv4[j][0] = *(const f32x4*)(pscale + ch); pv4[j][1] = *(const f32x4*)(pscale + ch + 4);
                gv4[j][0] = *(const f32x4*)(g1 + ch); gv4[j][1] = *(const f32x4*)(g1 + ch + 4); }
#pragma unroll
            for (int j = 0; j < 4; ++j) { const int ch = chb + 64 * j;
                const f32x4 z0 = (f32x4){bf_lo(zc[j].x), bf_hi(zc[j].x), bf_lo(zc[j].y), bf_hi(zc[j].y)}, z1 = (f32x4){bf_lo(zc[j].z), bf_hi(zc[j].z), bf_lo(zc[j].w), bf_hi(zc[j].w)};
                const f32x4 y0 = (Hs[j][0] * inv - z0) * pv4[j][0], y1 = (Hs[j][1] * inv - z1) * pv4[j][1];
                *(f32x4*)(LAT + row * 1024 + ch) = xv[j][0] + gv4[j][0] * y0;
                *(f32x4*)(LAT + row * 1024 + ch + 4) = xv[j][1] + gv4[j][1] * y1; }
            __syncthreads();
        } else {
            const int q = item - 2048, b = q >> 4, sc4 = (q >> 2) & 3, g = q & 3, hw = 1 << g;
            const int s = sc4 * 64 + tk, c0 = max(s - hw, 0), c1 = min(s + hw, 256);
            const int chb = g * 256 + sub * 8;
            f32x4 Hs[4][2];
#pragma unroll
            for (int j = 0; j < 4; ++j) { Hs[j][0] = (f32x4){0.f, 0.f, 0.f, 0.f}; Hs[j][1] = (f32x4){0.f, 0.f, 0.f, 0.f}; }
            for (int cb = c0; cb < c1; cb += 8) {
                u32x4 w8[8][4];
#pragma unroll
                for (int q8 = 0; q8 < 8; ++q8) { const int cc = min(cb + q8, c1 - 1); const bf16_t* zp = Z + ((size_t)(NL + b * 256 + cc)) * 1024 + chb;
#pragma unroll
                    for (int j = 0; j < 4; ++j) w8[q8][j] = *(const u32x4*)(zp + 64 * j); }
#pragma unroll
                for (int q8 = 0; q8 < 8; ++q8) { const float wq = (cb + q8 < c1) ? 1.0f : 0.0f;
#pragma unroll
                    for (int j = 0; j < 4; ++j) { const u32x4 w = w8[q8][j];
                        Hs[j][0] += wq * (f32x4){bf_lo(w.x), bf_hi(w.x), bf_lo(w.y), bf_hi(w.y)}; Hs[j][1] += wq * (f32x4){bf_lo(w.z), bf_hi(w.z), bf_lo(w.w), bf_hi(w.w)}; } }
            }
            const float inv = 1.0f / (float)(c1 - c0);
            const size_t crow = (size_t)b * 256 + s, row = NL + crow;
            const float* g1 = mod + (size_t)8 * 6144 + 2048;
            f32x4 xv[4][2], pv4[4][2], gv4[4][2]; u32x4 zw[4];
#pragma unroll
            for (int j = 0; j < 4; ++j) { const int ch = chb + 64 * j; zw[j] = *(const u32x4*)(Z + row * 1024 + ch);
                xv[j][0] = *(const f32x4*)(cin + crow * 1024 + ch); xv[j][1] = *(const f32x4*)(cin + crow * 1024 + ch + 4);
                pv4[j][0] = *(const f32x4*)(pscale + ch); pv4[j][1] = *(const f32x4*)(pscale + ch + 4);
                gv4[j][0] = *(const f32x4*)(g1 + ch); gv4[j][1] = *(const f32x4*)(g1 + ch + 4); }
#pragma unroll
            for (int j = 0; j < 4; ++j) { const int ch = chb + 64 * j; const u32x4 w = zw[j];
                const f32x4 z0 = (f32x4){bf_lo(w.x), bf_hi(w.x), bf_lo(w.y), bf_hi(w.y)}, z1 = (f32x4){bf_lo(w.z), bf_hi(w.z), bf_lo(w.w), bf_hi(w.w)};
                const f32x4 y0 = (Hs[j][0] * inv - z0) * pv4[j][0], y1 = (Hs[j][1] * inv - z1) * pv4[j][1];
                *(f32x4*)(LAT + row * 1024 + ch) = xv[j][0] + gv4[j][0] * y0;
                *(f32x4*)(LAT + row * 1024 + ch + 4) = xv[j][1] + gv4[j][1] * y1; }
        }
    }
}

template <bool FINAL>
__device__ __forceinline__ void combine_phase(const Params& p, LAS unsigned char* lds, int bid, int G, int ntok, const float* gain, int mod_l, int sh_off, int comb_l) {
    unsigned char* const ws = launder_ptr(p.ws);
    const int tid = my_tid(), lane = tid & 63, wave = tid >> 6;
    const float* mod = (const float*)(ws + WS_MOD);
    float* LAT = (float*)(ws + WS_LAT);
    bf16_t* H = (bf16_t*)(ws + WS_H);
    const int* TKE = (const int*)(ws + WS_TKE); const float* TKW = (const float*)(ws + WS_TKW); const int* POS = (const int*)(ws + WS_POS);
    const bf16_t* OUTB = (const bf16_t*)(ws + WS_OUTB);
    LAS int* tab = (LAS int*)(lds + 98304 + 256);
    moe_table(tab, (const int*)(ws + WS_CTL + CTL_CNT + 256 * comb_l));
    float* const outp = FINAL ? (float*)launder_ptr(p.out) : nullptr;
    const int npair = ntok >> 1, pstride = G * 8;
    int pi = bid * 8 + wave;
    i32x4 ev[2], pv[2]; f32x4 wv[2];
    if (pi < npair) {
#pragma unroll
        for (int s = 0; s < 2; ++s) { const size_t t4 = (size_t)(2 * pi + s) * 4; ev[s] = *(const i32x4*)(TKE + t4); pv[s] = *(const i32x4*)(POS + t4); wv[s] = *(const f32x4*)(TKW + t4); }
    }
    for (; pi < npair; pi += pstride) {
        const int tok0 = 2 * pi;
        const int bi = tok0 < NL ? (tok0 >> 12) : 8;
        f32x4 v[2][4]; u32x2 orw[2][4][4]; f32x4 wcur[2];
#pragma unroll
        for (int s = 0; s < 2; ++s) {
            wcur[s] = wv[s];
#pragma unroll
            for (int j = 0; j < 4; ++j) v[s][j] = *(const f32x4*)(LAT + (size_t)(tok0 + s) * 1024 + 256 * j + 4 * lane);
#pragma unroll
            for (int k = 0; k < 4; ++k) { const int slot = tab[ev[s][k]] * 256 + pv[s][k]; const bf16_t* op = OUTB + (size_t)slot * 1024 + 4 * lane;
#pragma unroll
                for (int j = 0; j < 4; ++j) orw[s][k][j] = *(const u32x2*)(op + 256 * j); }
        }
        f32x4 g2v[4], gnv[4], scv[4], shv[4];
        { const float* g2 = mod + ((size_t)comb_l * 9 + bi) * 6144 + 5120; const float* mb = mod + ((size_t)mod_l * 9 + bi) * 6144 + sh_off;
#pragma unroll
          for (int j = 0; j < 4; ++j) { const int ch = 256 * j + 4 * lane; g2v[j] = *(const f32x4*)(g2 + ch); gnv[j] = *(const f32x4*)(gain + ch);
              if (!FINAL) { shv[j] = *(const f32x4*)(mb + ch); scv[j] = *(const f32x4*)(mb + 1024 + ch); } } }
        { const int pn = pi + pstride;
          if (pn < npair) {
#pragma unroll
              for (int s = 0; s < 2; ++s) { const size_t t4 = (size_t)(2 * pn + s) * 4; ev[s] = *(const i32x4*)(TKE + t4); pv[s] = *(const i32x4*)(POS + t4); wv[s] = *(const f32x4*)(TKW + t4); } } }
        float ss[2];
#pragma unroll
        for (int s = 0; s < 2; ++s) {
            ss[s] = 0.f;
#pragma unroll
            for (int j = 0; j < 4; ++j) { f32x4 y = (f32x4){0.f, 0.f, 0.f, 0.f};
#pragma unroll
                for (int k = 0; k < 4; ++k) y += wcur[s][k] * unpack4(orw[s][k][j]);
                v[s][j] += g2v[j] * y;
                if (!FINAL) *(f32x4*)(LAT + (size_t)(tok0 + s) * 1024 + 256 * j + 4 * lane) = v[s][j];
                ss[s] += v[s][j][0] * v[s][j][0] + v[s][j][1] * v[s][j][1] + v[s][j][2] * v[s][j][2] + v[s][j][3] * v[s][j][3]; }
        }
#pragma unroll
        for (int o = 1; o < 64; o <<= 1) { ss[0] += __shfl_xor(ss[0], o); ss[1] += __shfl_xor(ss[1], o); }
#pragma unroll
        for (int s = 0; s < 2; ++s) {
            const float rstd = rsqrtf(ss[s] * (1.0f / 1024.0f) + 1e-6f);
#pragma unroll
            for (int j = 0; j < 4; ++j) { const int ch = 256 * j + 4 * lane;
                if (FINAL) *(f32x4*)(outp + (size_t)(tok0 + s) * 1024 + ch) = v[s][j] * rstd * gnv[j];
                else *(u32x2*)(H + (size_t)(tok0 + s) * 1024 + ch) = pack4(v[s][j] * rstd * gnv[j] * (1.0f + scv[j]) + shv[j]); }
        }
    }
}

__device__ __forceinline__ void router_phase(const Params& p, LAS unsigned char* lds, int bid, int G, int ntok, const float* gain, int mod_l, int sh_off, int rt_l) {
    unsigned char* const ws = launder_ptr(p.ws);
    const int tid = my_tid(), lane = tid & 63, wave = tid >> 6;
    const float* mod = (const float*)(ws + WS_MOD);
    const float* LAT = (const float*)(ws + WS_LAT);
    unsigned char* H8 = ws + WS_H8;
    int* TKE = (int*)(ws + WS_TKE); float* TKW = (float*)(ws + WS_TKW); int* POS = (int*)(ws + WS_POS);
    LAS float* hs = (LAS float*)lds;
    LAS float* part = (LAS float*)(lds + 65536);
    LAS int* hist = (LAS int*)(lds + 98304);
    LAS int* basev = (LAS int*)(lds + 98304 + 128);
    if (tid < 32) hist[tid] = 0;
    float Wreg[64];
    const int re = lane & 31, rq = lane >> 5;
    const float rbias = kin(20)[rt_l * 32 + re];
    { const float* rw = kin(19) + (size_t)rt_l * 1024 * 32;
#pragma unroll
      for (int i = 0; i < 64; ++i) Wreg[i] = rw[(size_t)(128 * wave + 64 * rq + i) * 32 + re]; }
    f32x4 gn[4];
#pragma unroll
    for (int j = 0; j < 4; ++j) gn[j] = *(const f32x4*)(gain + 256 * j + 4 * lane);
    const int nb = ntok >> 4;
    f32x4 lat[2][4], scv[4], shv[4];
#define RT_ISSUE(btx) do { const int _t0 = (btx) * 16 + wave * 2; const int _bi = _t0 < NL ? (_t0 >> 12) : 8; const float* _mb = mod + ((size_t)mod_l * 9 + _bi) * 6144 + sh_off; \
        _Pragma("unroll") for (int j = 0; j < 4; ++j) { lat[0][j] = *(const f32x4*)(LAT + (size_t)_t0 * 1024 + 256 * j + 4 * lane); lat[1][j] = *(const f32x4*)(LAT + (size_t)(_t0 + 1) * 1024 + 256 * j + 4 * lane); \
            shv[j] = *(const f32x4*)(_mb + 256 * j + 4 * lane); scv[j] = *(const f32x4*)(_mb + 1024 + 256 * j + 4 * lane); } } while (0)
    if (bid < nb) RT_ISSUE(bid);
    for (int bt = bid; bt < nb; bt += G) {
        float ss0 = 0.f, ss1 = 0.f;
#pragma unroll
        for (int j = 0; j < 4; ++j) { ss0 += lat[0][j][0] * lat[0][j][0] + lat[0][j][1] * lat[0][j][1] + lat[0][j][2] * lat[0][j][2] + lat[0][j][3] * lat[0][j][3];
                                      ss1 += lat[1][j][0] * lat[1][j][0] + lat[1][j][1] * lat[1][j][1] + lat[1][j][2] * lat[1][j][2] + lat[1][j][3] * lat[1][j][3]; }
#pragma unroll
        for (int o = 1; o < 64; o <<= 1) { ss0 += __shfl_xor(ss0, o); ss1 += __shfl_xor(ss1, o); }
        const float rs0 = rsqrtf(ss0 * (1.0f / 1024.0f) + 1e-6f), rs1 = rsqrtf(ss1 * (1.0f / 1024.0f) + 1e-6f);
        const int tok0 = bt * 16 + wave * 2;
#pragma unroll
        for (int j = 0; j < 4; ++j) { const int ch = 256 * j + 4 * lane; const f32x4 gm = gn[j] * (1.0f + scv[j]);
            const f32x4 h0 = lat[0][j] * rs0 * gm + shv[j], h1 = lat[1][j] * rs1 * gm + shv[j];
            *(unsigned*)(H8 + (size_t)tok0 * 1024 + ch) = pack4_fp8(h0); *(unsigned*)(H8 + (size_t)(tok0 + 1) * 1024 + ch) = pack4_fp8(h1);
            *(LAS f32x4*)(hs + (wave * 2) * 1024 + ch) = h0; *(LAS f32x4*)(hs + (wave * 2 + 1) * 1024 + ch) = h1; }
        if (bt + G < nb) RT_ISSUE(bt + G);
        __syncthreads();
#pragma unroll 1
        for (int t16 = 0; t16 < 16; ++t16) {
            f32x2 a2 = (f32x2){0.f, 0.f};
#pragma unroll
            for (int hb = 0; hb < 2; ++hb) {
                f32x4 hv[8];
#pragma unroll
                for (int i4 = 0; i4 < 8; ++i4) hv[i4] = *(const LAS f32x4*)(hs + t16 * 1024 + 128 * wave + 64 * rq + 32 * hb + 4 * i4);
#pragma unroll
                for (int i4 = 0; i4 < 8; ++i4) { const int w0 = 32 * hb + 4 * i4;
                    a2 = __builtin_elementwise_fma((f32x2){hv[i4][0], hv[i4][1]}, (f32x2){Wreg[w0], Wreg[w0 + 1]}, a2); a2 = __builtin_elementwise_fma((f32x2){hv[i4][2], hv[i4][3]}, (f32x2){Wreg[w0 + 2], Wreg[w0 + 3]}, a2); }
            }
            part[(t16 * 16 + wave * 2 + rq) * 32 + re] = a2[0] + a2[1];
        }
        __syncthreads();
        {
            const int t16 = tid >> 5, e = tid & 31, tok = bt * 16 + t16;
            float v = rbias;
#pragma unroll
            for (int sct = 0; sct < 16; ++sct) v += part[(t16 * 16 + sct) * 32 + e];
            LAS float* lg = (LAS float*)(lds + 98304 + 1024) + t16 * 64;
            lg[e] = v;
            int rank = 0;
#pragma unroll
            for (int q4 = 0; q4 < 8; ++q4) { const f32x4 o = *(const LAS f32x4*)(lg + 4 * q4);
#pragma unroll
                for (int c = 0; c < 4; ++c) { const int j = 4 * q4 + c; rank += (o[c] > v || (o[c] == v && j < e)) ? 1 : 0; } }
            if (rank < 4) lg[32 + rank] = v;
            const f32x4 tv = *(const LAS f32x4*)(lg + 32);
            const float e0 = 1.0f, e1 = __expf(tv[1] - tv[0]), e2 = __expf(tv[2] - tv[0]), e3 = __expf(tv[3] - tv[0]);
            const float inv = 1.0f / (e0 + e1 + e2 + e3);
            if (rank < 4) { const float mye = __expf(v - tv[0]); TKE[(size_t)tok * 4 + rank] = e; TKW[(size_t)tok * 4 + rank] = mye * inv; POS[(size_t)tok * 4 + rank] = atomicAdd((int*)&hist[e], 1); }
        }
    }
#undef RT_ISSUE
    __syncthreads();
    if (tid < 32) basev[tid] = atomicAdd((int*)(ws + WS_CTL + CTL_CNT + 256 * rt_l) + tid, hist[tid]);
    __syncthreads();
    { int* LIST = (int*)(ws + WS_LIST);
      for (int bt = bid; bt < nb; bt += G) {
          if (tid < 64) { const int tok = bt * 16 + (tid >> 2), k = tid & 3; const int e = TKE[(size_t)tok * 4 + k]; const int pos = basev[e] + POS[(size_t)tok * 4 + k];
              POS[(size_t)tok * 4 + k] = pos; LIST[(size_t)e * NT0 + pos] = tok; } } }
}

__device__ __forceinline__ void phase_conv(const Params& p, int bid, int G) {
    unsigned char* const ws = launder_ptr(p.ws);
    const bf16_t* UP = (const bf16_t*)(ws + WS_Z); bf16_t* U = (bf16_t*)(ws + WS_U);
    const int tid = my_tid();
    const float* cw = kin(11); const float* cb = kin(12);
    const int ch = (tid & 127) * 8;
    f32x4 wk[4][2], bsv[2];
#pragma unroll
    for (int k = 0; k < 4; ++k) { wk[k][0] = *(const f32x4*)(cw + k * 1024 + ch); wk[k][1] = *(const f32x4*)(cw + k * 1024 + ch + 4); }
    bsv[0] = *(const f32x4*)(cb + ch); bsv[1] = *(const f32x4*)(cb + ch + 4);
    for (int g4 = bid * 4 + (tid >> 7); g4 < NT0 / 4; g4 += G * 4) {
        const int row0 = g4 * 4;
        int pos0, len; if (row0 < NL) { pos0 = row0 & 4095; len = 4096; } else { pos0 = (row0 - NL) & 255; len = 256; }
        u32x4 x[7];
#pragma unroll
        for (int j = 0; j < 7; ++j) { const int pp = pos0 + j - 2; x[j] = (pp >= 0 && pp < len) ? *(const u32x4*)(UP + (size_t)(row0 + j - 2) * 1024 + ch) : (u32x4){0u, 0u, 0u, 0u}; }
#pragma unroll
        for (int r = 0; r < 4; ++r) {
            f32x4 a0 = bsv[0], a1 = bsv[1];
#pragma unroll
            for (int k = 0; k < 4; ++k) { const u32x4 w = x[r + k];
                a0 += wk[k][0] * (f32x4){bf_lo(w.x), bf_hi(w.x), bf_lo(w.y), bf_hi(w.y)}; a1 += wk[k][1] * (f32x4){bf_lo(w.z), bf_hi(w.z), bf_lo(w.w), bf_hi(w.w)}; }
            u32x4 o; o.x = cvt_pk_bf16(a0[0], a0[1]); o.y = cvt_pk_bf16(a0[2], a0[3]); o.z = cvt_pk_bf16(a1[0], a1[1]); o.w = cvt_pk_bf16(a1[2], a1[3]);
            *(u32x4*)(U + (size_t)(row0 + r) * 1024 + ch) = o;
        }
    }
}
__device__ __forceinline__ int seq_row(int b, int dir, int pp) {
    if (pp < 256) return NL + b * 256 + (dir ? 255 - pp : pp);
    const int t = pp - 256; return b * 4096 + (dir ? 4095 - t : t);
}
__device__ __forceinline__ void phase_scan_a(const Params& p, int bid, int G) {
    unsigned char* const ws = launder_ptr(p.ws);
    const bf16_t* LA = (const bf16_t*)(ws + WS_LA); const bf16_t* BBp = (const bf16_t*)(ws + WS_BB);
    float* AGL = (float*)(ws + WS_AGL); float* AGS = (float*)(ws + WS_AGS);
    const int tid = my_tid(), sub = tid >> 8, ch = (tid & 255) * 4;
    for (int it2 = bid; it2 < 1088; it2 += G) {
        const int item = it2 * 2 + sub;
        const int b = item / 272, rem = item % 272, dir = rem / 136, c = rem % 136;
        const int rfirst = seq_row(b, dir, c * 32), rstep = dir ? -1 : 1;
        const size_t base = ((size_t)dir * NT0 + rfirst) * 1024 + ch;
        f32x4 S = (f32x4){0.f, 0.f, 0.f, 0.f}, Ls = (f32x4){0.f, 0.f, 0.f, 0.f};
#pragma unroll 1
        for (int s0 = 0; s0 < 32; s0 += 8) {
            u32x2 la[8], bb[8];
#pragma unroll
            for (int s = 0; s < 8; ++s) { const long o = (long)base + (long)((s0 + s) * rstep) * 1024; la[s] = *(const u32x2*)(LA + o); bb[s] = *(const u32x2*)(BBp + o); }
#pragma unroll
            for (int s = 0; s < 8; ++s) { const f32x4 l = unpack4(la[s]), bv = unpack4(bb[s]);
#pragma unroll
                for (int q = 0; q < 4; ++q) { S[q] = ex2(l[q]) * S[q] + bv[q]; Ls[q] += l[q]; } }
        }
        *(f32x4*)(AGL + (size_t)item * 1024 + ch) = Ls; *(f32x4*)(AGS + (size_t)item * 1024 + ch) = S;
    }
}
__device__ __forceinline__ void phase_scan_b(const Params& p, int bid, int G) {
    unsigned char* const ws = launder_ptr(p.ws);
    const float* AGL = (const float*)(ws + WS_AGL); const float* AGS = (const float*)(ws + WS_AGS); float* CAR = (float*)(ws + WS_CAR);
    const int tid = my_tid(); if (tid >= 64) return;
    for (int q = bid; q < 256; q += G) {
        const int bd = q >> 4, ch = (q & 15) * 64 + tid; float h = 0.f;
#pragma unroll 1
        for (int c0 = 0; c0 < 136; c0 += 8) {
            float l[8], sv[8];
#pragma unroll
            for (int c = 0; c < 8; ++c) { const size_t o = ((size_t)bd * 136 + c0 + c) * 1024 + ch; l[c] = AGL[o]; sv[c] = AGS[o]; }
#pragma unroll
            for (int c = 0; c < 8; ++c) { const size_t o = ((size_t)bd * 136 + c0 + c) * 1024 + ch; CAR[o] = h; h = ex2(l[c]) * h + sv[c]; }
        }
    }
}
__device__ __forceinline__ void phase_scan_c(const Params& p, LAS unsigned char* lds, int bid, int G) {
    unsigned char* const ws = launder_ptr(p.ws);
    const bf16_t* LA = (const bf16_t*)(ws + WS_LA); const bf16_t* BBp = (const bf16_t*)(ws + WS_BB); const float* CAR = (const float*)(ws + WS_CAR);
    const bf16_t* GATE = (const bf16_t*)(ws + WS_GATE); bf16_t* HG = (bf16_t*)(ws + WS_HG);
    const int tid = my_tid(), sub = tid >> 8, t256 = tid & 255, ch = t256 * 4;
    LAS u32x2* scr = (LAS u32x2*)lds + (size_t)sub * 32 * 256 + t256;
    for (int it2 = bid; it2 < 512; it2 += G) {
        const int item = it2 * 2 + sub, b = item >> 7, j = item & 127;
        const size_t row0 = (size_t)b * 4096 + 32 * j;
        f32x4 h = *(const f32x4*)(CAR + ((size_t)(b * 2 + 1) * 136 + (135 - j)) * 1024 + ch);
#pragma unroll 1
        for (int t0 = 24; t0 >= 0; t0 -= 8) {
            u32x2 la[8], bb[8];
#pragma unroll
            for (int s = 0; s < 8; ++s) { const size_t o = ((size_t)NT0 + row0 + t0 + s) * 1024 + ch; la[s] = *(const u32x2*)(LA + o); bb[s] = *(const u32x2*)(BBp + o); }
#pragma unroll
            for (int s = 7; s >= 0; --s) { const f32x4 l = unpack4(la[s]), bv = unpack4(bb[s]);
#pragma unroll
                for (int q = 0; q < 4; ++q) h[q] = ex2(l[q]) * h[q] + bv[q];
                scr[(t0 + s) * 256] = pack4(h); }
        }
        h = *(const f32x4*)(CAR + ((size_t)(b * 2 + 0) * 136 + (8 + j)) * 1024 + ch);
#pragma unroll 1
        for (int t0 = 0; t0 < 32; t0 += 8) {
            u32x2 la[8], bb[8], gt[8];
#pragma unroll
            for (int s = 0; s < 8; ++s) { const size_t o = (row0 + t0 + s) * 1024 + ch; la[s] = *(const u32x2*)(LA + o); bb[s] = *(const u32x2*)(BBp + o); gt[s] = *(const u32x2*)(GATE + o); }
#pragma unroll
            for (int s = 0; s < 8; ++s) { const f32x4 l = unpack4(la[s]), bv = unpack4(bb[s]);
#pragma unroll
                for (int q = 0; q < 4; ++q) h[q] = ex2(l[q]) * h[q] + bv[q];
                const f32x4 rec = h + unpack4(scr[(t0 + s) * 256]);
                *(u32x2*)(HG + (row0 + t0 + s) * 1024 + ch) = pack4(unpack4(gt[s]) * rec); }
        }
    }
}


#define XB_TMO      128
#define XB_XCNT(j)  (256  + 64 * (j))
#define XB_XSUB(j)  (1280 + 64 * (j))
#define XB_XGEN(j)  (2304 + 64 * (j))
#define XB_TOP      3328
#define XB_TOPGEN   3392
#define XCD_BAR_WORDS 3456
#define XB_SPIN_CAP (1u << 21)
__device__ __forceinline__ unsigned xb_ld(unsigned* p)              { return __hip_atomic_load(p, __ATOMIC_RELAXED, __HIP_MEMORY_SCOPE_AGENT); }
__device__ __forceinline__ unsigned xb_add(unsigned* p, unsigned v) { return __hip_atomic_fetch_add(p, v, __ATOMIC_RELAXED, __HIP_MEMORY_SCOPE_AGENT); }
__device__ __forceinline__ unsigned xb_xcc_id() { return (unsigned)__builtin_amdgcn_s_getreg((3 << 11) | 20) & 0xFu; }
#define XB_SPIN(cond, bar) do { unsigned _sp = 0; while (cond) { __builtin_amdgcn_s_sleep(1); \
    if ((++_sp & 255u) == 0u) { if (xb_ld(&(bar)[XB_TMO])) break; if (_sp > XB_SPIN_CAP) { atomicAdd(&(bar)[XB_TMO], 1u); break; } } } } while (0)
struct XcdBarrier { unsigned* bar; unsigned x; volatile LAS unsigned* st; };
__device__ __forceinline__ XcdBarrier xcd_barrier_post(unsigned* bar, volatile LAS unsigned* st) {
    XcdBarrier b; b.bar = bar; b.x = xb_xcc_id(); b.st = st;
    if (threadIdx.x == 0) (void)xb_add(&bar[XB_XCNT(b.x)], 1u);
    return b;
}
__device__ __forceinline__ void xcd_barrier_complete(unsigned* bar, unsigned x, unsigned& nloc, unsigned& nx) {
    const unsigned G = gridDim.x * gridDim.y * gridDim.z;
    unsigned sum, cnt, mine, sp = 0u;
    for (;;) {
        sum = 0u; cnt = 0u; mine = 0u;
#pragma unroll
        for (unsigned j = 0; j < 16; ++j) { const unsigned c = xb_ld(&bar[XB_XCNT(j)]); sum += c; cnt += (c > 0u) ? 1u : 0u; mine = (j == x) ? c : mine; }
        if (sum == G) break;
        __builtin_amdgcn_s_sleep(1);
        if ((++sp & 255u) == 0u) { if (xb_ld(&bar[XB_TMO])) break; if (sp > XB_SPIN_CAP) { atomicAdd(&bar[XB_TMO], 1u); break; } }
    }
    nloc = mine > 0u ? mine : 1u; nx = cnt > 0u ? cnt : 1u;
}
__device__ __forceinline__ void xcd_barrier(const XcdBarrier& b) {
    asm volatile("s_waitcnt vmcnt(0)" ::: "memory");
    __syncthreads();
    if (threadIdx.x == 0) {
        unsigned* bar = b.bar;
        __builtin_amdgcn_s_waitcnt(0);
        unsigned nloc = b.st[0], nx = b.st[1];
        if (nloc == 0u) { xcd_barrier_complete(bar, b.x, nloc, nx); b.st[0] = nloc; b.st[1] = nx; }
        const unsigned old = xb_add(&bar[XB_XSUB(b.x)], 1u);
        const unsigned gen = old / nloc;
        if (old + 1u == (gen + 1u) * nloc) {
            __builtin_amdgcn_fence(__ATOMIC_RELEASE, "agent");
            asm volatile("s_waitcnt vmcnt(0)" ::: "memory");
            const unsigned og = xb_add(&bar[XB_TOP], 1u);
            const unsigned tg = og / nx;
            if (og + 1u == (tg + 1u) * nx) xb_add(&bar[XB_TOPGEN], 1u);
            else XB_SPIN(xb_ld(&bar[XB_TOPGEN]) == tg, bar);
            __builtin_amdgcn_fence(__ATOMIC_ACQUIRE, "agent");
            xb_add(&bar[XB_XGEN(b.x)], 1u);
            asm volatile("s_waitcnt vmcnt(0)" ::: "memory");
        } else {
            XB_SPIN(xb_ld(&bar[XB_XGEN(b.x)]) == gen, bar);
            __builtin_amdgcn_fence(__ATOMIC_ACQUIRE, "agent");
            asm volatile("s_waitcnt vmcnt(0)" ::: "memory");
        }
    }
    __syncthreads();
}

__device__ __forceinline__ void run_phase(const Params& p, LAS unsigned char* lds, int ph, int bid, int vid, int G) {
    asm volatile("" : "+s"(bid), "+s"(vid), "+s"(G));
    unsigned char* const ws = launder_ptr(p.ws);
    LAS int* tab = (LAS int*)(lds + pg8::STAGE_BYTES);
    const float* mod = (const float*)(ws + WS_MOD);
    switch (ph) {
    case 0: phase_prep(p, lds, bid, G); break;
    case 1: phase_norm0(p, bid, G); break;
    case 2: { ProbPool P{(unsigned)WS_H, 256, (unsigned)WS_WPOOL, (bf16_t*)(ws + WS_Z)}; pg8::gemm_phase<256, true>(lds, (const char*)ws, P, vid, G); } break;
    case 3: phase_pool(p, lds, bid, G); break;
    case 4: router_phase(p, lds, bid, G, NT0, kin(7), 0, 3072, 0); break;
    case 5: { moe_table(tab, (const int*)(ws + WS_CTL + CTL_CNT));
              ProbMoe1 P{(unsigned)WS_H8, 512, (unsigned)WS_WGU, tab, (const int*)(ws + WS_LIST), kin(22), (bf16_t*)(ws + WS_ACT)}; pg8::gemm_phase<512, true, 0, true>(lds, (const char*)ws, P, vid, G); } break;
    case 6: { moe_table(tab, (const int*)(ws + WS_CTL + CTL_CNT));
              ProbMoe2 P{(unsigned)WS_ACT, 512, (unsigned)WS_WDN, tab, kin(24), (bf16_t*)(ws + WS_OUTB)}; pg8::gemm_phase<512, true, 0, true>(lds, (const char*)ws, P, vid, G); } break;
    case 7: combine_phase<false>(p, lds, bid, G, NT0, kin(6) + 1024, 1, 0, 0); break;
    case 8: { ProbIn P{(unsigned)WS_H, 1024, (unsigned)WS_WIN, (bf16_t*)(ws + WS_GATE), (bf16_t*)(ws + WS_Z)}; pg8::gemm_phase<1024, true>(lds, (const char*)ws, P, vid, G); } break;
    case 9: phase_conv(p, bid, G); break;
    case 10: { ProbGate P{(unsigned)WS_U, 256, (unsigned)WS_WGATE, (const bf16_t*)(ws + WS_U), kin(14), kin(16), (const float*)(ws + WS_CTL + CTL_SP8), (bf16_t*)(ws + WS_LA), (bf16_t*)(ws + WS_BB)};
               pg8::gemm_phase<256, true>(lds, (const char*)ws, P, vid, G); } break;
    case 11: phase_scan_a(p, bid, G); break;
    case 12: phase_scan_b(p, bid, G); break;
    case 13: phase_scan_c(p, lds, bid, G); break;
    case 14: { ProbOut P{(unsigned)WS_HG, 1024, (unsigned)WS_WOUT, mod + (size_t)9 * 6144 + 2048, (float*)(ws + WS_LAT)}; pg8::gemm_phase<1024, false>(lds, (const char*)ws, P, vid, G); } break;
    case 15: router_phase(p, lds, bid, G, NL, kin(7) + 1024, 1, 3072, 1); break;
    case 16: { moe_table(tab, (const int*)(ws + WS_CTL + CTL_CNT + 256));
               ProbMoe1 P{(unsigned)WS_H8, 512, (unsigned)(WS_WGU + (size_t)32 * 2048 * 1024), tab, (const int*)(ws + WS_LIST), kin(22) + 32 * 2048, (bf16_t*)(ws + WS_ACT)}; pg8::gemm_phase<512, true, 0, true>(lds, (const char*)ws, P, vid, G); } break;
    case 17: { moe_table(tab, (const int*)(ws + WS_CTL + CTL_CNT + 256));
               ProbMoe2 P{(unsigned)WS_ACT, 512, (unsigned)(WS_WDN + (size_t)32 * 1024 * 1024), tab, kin(24) + 32 * 1024, (bf16_t*)(ws + WS_OUTB)}; pg8::gemm_phase<512, true, 0, true>(lds, (const char*)ws, P, vid, G); } break;
    case 18: combine_phase<true>(p, lds, bid, G, NL, kin(25), 0, 0, 1); break;
#ifdef PROBE_ABL
    case 21: { moe_table(tab, (const int*)(ws + WS_CTL + CTL_CNT));
              ProbMoe1 P{(unsigned)WS_H8, 512, (unsigned)WS_WGU, tab, (const int*)(ws + WS_LIST), kin(22), (bf16_t*)(ws + WS_END)}; pg8::gemm_phase<512, true, PROBE_ABL, true>(lds, (const char*)ws, P, vid, G); } break;
#endif
    default: break;
    }
}

__global__ void __launch_bounds__(512, 2) mega(Params p) {
    extern __shared__ __attribute__((aligned(16))) unsigned char shm[];
    LAS unsigned char* lds = (LAS unsigned char*)shm;
    const int G = gridDim.x, bid = blockIdx.x;
    const int vid = (G & 7) ? bid : ((bid & 7) * (G >> 3) + (bid >> 3));
    volatile LAS unsigned* xst = (volatile LAS unsigned*)(lds + LDS_BYTES - 16);
    if (threadIdx.x == 0) { xst[0] = 0u; xst[1] = 0u; }
    __syncthreads();
    XcdBarrier xb = xcd_barrier_post((unsigned*)(p.ws + WS_CTL), xst);
    for (int ph = p.ph_lo; ph < p.ph_hi; ++ph) {
#if defined(PROBE_ABL)
        run_phase(p, lds, ph <= 5 ? ph : (ph == 6 ? 21 : ph - 1), bid, vid, G);
#elif defined(PROBE_DUP)
        run_phase(p, lds, ph <= PROBE_DUP ? ph : (ph <= PROBE_DUP + PROBE_REPS ? PROBE_DUP : ph - PROBE_REPS), bid, vid, G);
#else
        run_phase(p, lds, ph, bid, vid, G);
#endif
        if (ph + 1 < p.ph_hi) { if (p.ph_hi > 1000) cg::this_grid().sync(); else xcd_barrier(xb); }
    }
}

extern "C" void kernel_launch(void* const* d_in, const int* in_sizes, int n_in, void* d_out, int out_size, void* d_ws, size_t ws_size, hipStream_t stream) {
    static int grid = 0;
    if (grid == 0) {
        if (n_in != 26 || ws_size < WS_END) { fprintf(stderr, "kernel_launch: unexpected inputs (n_in %d, ws %zu, need %zu)\n", n_in, ws_size, (size_t)WS_END); grid = -1; return; }
        int dev = 0, cus = 0;
        if (hipGetDevice(&dev) != hipSuccess || hipDeviceGetAttribute(&cus, hipDeviceAttributeMultiprocessorCount, dev) != hipSuccess) { grid = -1; return; }
        if (hipFuncSetAttribute((const void*)mega, hipFuncAttributeMaxDynamicSharedMemorySize, LDS_BYTES) != hipSuccess) { fprintf(stderr, "kernel_launch: hipFuncSetAttribute failed\n"); grid = -1; return; }
        int per_cu = 0;
        if (hipOccupancyMaxActiveBlocksPerMultiprocessor(&per_cu, (const void*)mega, NTHR, LDS_BYTES) != hipSuccess || per_cu < 1) { fprintf(stderr, "kernel_launch: occupancy query says %d blocks per CU\n", per_cu); (void)hipGetLastError(); }
        grid = (cus < 256 ? cus : 256) & ~7;
        if (grid < 8) { fprintf(stderr, "kernel_launch: too few CUs (%d)\n", cus); grid = -1; return; }
    }
    if (grid < 0) return;
    (void)hipMemsetAsync((char*)d_ws + WS_CTL, 0, 65536, stream);
    Params p{};
    for (int i = 0; i < 26; ++i) p.in[i] = (const float*)d_in[i];
    p.out = (float*)d_out; p.ws = (unsigned char*)d_ws;
#if N_LAUNCH_MODE == 0
    for (int ph = 0; ph < NPHASE; ++ph) { p.ph_lo = ph; p.ph_hi = ph + 1; hipLaunchKernelGGL(mega, dim3(grid), dim3(NTHR), LDS_BYTES, stream, p); }
#else
#if defined(PROBE_DUP)
    p.ph_lo = 0; p.ph_hi = NPHASE + PROBE_REPS;
#elif defined(PROBE_ABL)
    p.ph_lo = 0; p.ph_hi = NPHASE + 1;
#else
    p.ph_lo = 0; p.ph_hi = NPHASE;
#endif
    void* args[] = {&p};
    hipError_t e = hipLaunchCooperativeKernel((const void*)mega, dim3(grid), dim3(NTHR), args, LDS_BYTES, stream);
    if (e != hipSuccess) fprintf(stderr, "cooperative launch failed: %s (grid %d)\n", hipGetErrorString(e), grid);
#endif
}
```

```cpp
#include <hip/hip_runtime.h>
#include <hip/hip_cooperative_groups.h>
#include <cstdio>
#include <cstdint>
namespace cg = cooperative_groups;

#ifndef N_LAUNCH_MODE
#define N_LAUNCH_MODE 1
#endif

#define LAS __attribute__((address_space(3)))
typedef unsigned short bf16_t;
typedef short bf16x8 __attribute__((ext_vector_type(8)));
typedef float f32x4 __attribute__((ext_vector_type(4)));
typedef float f32x2 __attribute__((ext_vector_type(2)));
typedef unsigned u32x4 __attribute__((ext_vector_type(4)));
typedef unsigned u32x2 __attribute__((ext_vector_type(2)));
typedef int i32x4 __attribute__((ext_vector_type(4)));

constexpr int D = 1024, NB = 8, T = 4096, NL = NB * T, CT = 256, NC = NB * CT, NT0 = NL + NC;
constexpr int NE = 32;
constexpr int NTHR = 512;
constexpr int LDS_BYTES = 147456;
constexpr int NPHASE = 19;

constexpr size_t WS_CTL   = 0;
constexpr size_t CTL_CNT  = 16384;
constexpr size_t CTL_BLK  = 32768;
constexpr size_t CTL_SP8  = 20480;
constexpr size_t CTL_Q    = 30720;
constexpr size_t CTL_DONE = 30784;
constexpr size_t CTL_Q0   = 31296;
constexpr size_t CTL_NRET = 31232;
constexpr size_t CTL_RET  = 32768;
constexpr unsigned NQ_ITEMS = 16384 + 8192;
constexpr int IDTAB = 131072 + 1024, BIASTAB = 131072 + 2048;
constexpr size_t WS_MOD   = 65536;
constexpr size_t WS_WGU   = 1048576;
constexpr size_t WS_H8    = WS_WGU + 134217728;
constexpr size_t WS_WDN   = WS_WGU + 268435456;
constexpr size_t WS_WPOOL = WS_WDN + 134217728;
constexpr size_t WS_WIN   = WS_WPOOL + 524288;
constexpr size_t WS_WGATE = WS_WIN + 4194304;
constexpr size_t WS_WOUT  = WS_WGATE + 2097152;
constexpr size_t WS_H     = WS_WOUT + 2097152;
constexpr size_t WS_Z     = WS_H + 71303168;
constexpr size_t WS_LAT   = WS_Z + 71303168;
constexpr size_t WS_TKE   = WS_LAT + 142606336;
constexpr size_t WS_TKW   = WS_TKE + 557056;
constexpr size_t WS_POS   = WS_TKW + 557056;
constexpr size_t WS_LIST  = WS_POS + 557056;
constexpr size_t WS_ACT   = WS_LIST + 4456448;
constexpr size_t WS_OUTB  = WS_ACT + 301989888;
constexpr size_t WS_END   = WS_OUTB + 301989888;
constexpr size_t WS_LA    = WS_ACT;
constexpr size_t WS_BB    = WS_ACT + 142606336;
constexpr size_t WS_GATE  = WS_OUTB;
constexpr size_t WS_U     = WS_GATE + 67108864;
constexpr size_t WS_HG    = WS_U + 71303168;
constexpr size_t WS_AGL   = WS_HG + 67108864;
constexpr size_t WS_AGS   = WS_AGL + 8912896;
constexpr size_t WS_CAR   = WS_AGS + 8912896;

struct Params {
    const float* in[26];
    float* out;
    unsigned char* ws;
    int ph_lo, ph_hi;
};

__device__ __forceinline__ unsigned cvt_pk_bf16(float lo, float hi) { unsigned r; asm("v_cvt_pk_bf16_f32 %0, %1, %2" : "=v"(r) : "v"(lo), "v"(hi)); return r; }
__device__ __forceinline__ float bf_lo(unsigned u) { return __uint_as_float(u << 16); }
__device__ __forceinline__ float bf_hi(unsigned u) { return __uint_as_float(u & 0xffff0000u); }
template <int O> __device__ __forceinline__ float sx(float v) {
    if constexpr (O < 32) return __int_as_float(__builtin_amdgcn_ds_swizzle(__float_as_int(v), (O << 10) | 0x1f));
    else { int l; asm volatile("v_mbcnt_lo_u32_b32 %0, -1, 0\n\tv_mbcnt_hi_u32_b32 %0, -1, %0" : "=v"(l)); return __int_as_float(__builtin_amdgcn_ds_bpermute((l ^ 32) << 2, __float_as_int(v))); }
}
__device__ __forceinline__ float wave_sum(float v) {
    v += sx<1>(v); v += sx<2>(v); v += sx<4>(v); v += sx<8>(v); v += sx<16>(v); v += sx<32>(v);
    return v;
}
__device__ __forceinline__ int my_tid(int wv) { int t; asm volatile("v_mbcnt_lo_u32_b32 %0, -1, 0\n\tv_mbcnt_hi_u32_b32 %0, -1, %0\n\tv_lshl_add_u32 %0, %1, 6, %0" : "=&v"(t) : "s"(wv)); return t; }
typedef __attribute__((address_space(4))) const unsigned long long* kargp_t;
#define GAS __attribute__((address_space(1)))
__device__ __forceinline__ const float* kin(int i) { kargp_t ka = (kargp_t)__builtin_amdgcn_kernarg_segment_ptr(); asm volatile("" : "+s"(ka)); return (const float*)(const GAS float*)ka[i]; }
__device__ __forceinline__ unsigned char* launder_ptr(const void* q) { unsigned long long w = (unsigned long long)q; asm volatile("" : "+s"(w)); return (unsigned char*)(GAS unsigned char*)w; }
__device__ __forceinline__ float fast_rcp(float x) { return __builtin_amdgcn_rcpf(x); }
__device__ __forceinline__ float ex2(float x) { return __builtin_amdgcn_exp2f(x); }
__device__ __forceinline__ float log1p_l2(float e) { const float u = 1.0f + e, d = u - 1.0f; return d == 0.0f ? e * 1.44269504089f : __builtin_amdgcn_logf(u) * e * fast_rcp(d); }
__device__ __forceinline__ float sigmoidf_(float x) { return fast_rcp(1.0f + __expf(-x)); }
__device__ __forceinline__ unsigned pack4_fp8(f32x4 v) { int w = 0; w = __builtin_amdgcn_cvt_pk_fp8_f32(v[0], v[1], w, false); w = __builtin_amdgcn_cvt_pk_fp8_f32(v[2], v[3], w, true); return (unsigned)w; }
__device__ __forceinline__ f32x4 unpack4_fp8(unsigned u) { const f32x2 lo = __builtin_amdgcn_cvt_pk_f32_fp8((int)u, false), hi = __builtin_amdgcn_cvt_pk_f32_fp8((int)u, true); return (f32x4){lo[0], lo[1], hi[0], hi[1]}; }
__device__ __forceinline__ u32x2 pack4(f32x4 v) { u32x2 r; r.x = cvt_pk_bf16(v[0], v[1]); r.y = cvt_pk_bf16(v[2], v[3]); return r; }
__device__ __forceinline__ f32x4 unpack4(u32x2 u) { f32x4 r; r[0] = bf_lo(u.x); r[1] = bf_hi(u.x); r[2] = bf_lo(u.y); r[3] = bf_hi(u.y); return r; }

namespace pg8 {
constexpr int BM = 256, BK = 64, HALF = 128, HTB = HALF * BK * 2, STAGE_BYTES = 8 * HTB;
__device__ __forceinline__ int lds_byte(int r, int c) { const int st = (r >> 4) * 2 + (c >> 5), rr = r & 15, cc = c & 31, ob = rr * 64 + cc * 2; return st * 1024 + (ob ^ (((ob >> 9) & 1) << 5)); }
__device__ __forceinline__ void stage_rc(int b, int& R, int& C) { const int st = b / 1024, sb = b % 1024, swz = sb ^ (((sb >> 9) & 1) << 5); R = (st >> 1) * 16 + swz / 64; C = (st & 1) * 32 + (swz % 64) / 2; }
__device__ __forceinline__ int perm32(int rho) { const int n = rho >> 4, i = rho & 15; return 8 * (i >> 2) + 4 * n + (i & 3); }

struct Unit { int pm, pn, e, aux; };
typedef int i32x8 __attribute__((ext_vector_type(8)));
typedef int i32x4v __attribute__((ext_vector_type(4)));

template <int K, bool PERM, int ABL = 0, bool F8 = false, class Prob>
__device__ __forceinline__ void gemm_phase(LAS unsigned char* lds, const char* base, const Prob& P, const int vid, const int G, const int wvi) {
    const int tid = my_tid(wvi), wid = __builtin_amdgcn_readfirstlane(tid >> 6), lane = tid & 63, wr = wid >> 2, wc = wid & 3, fr = lane & 15, fq = lane >> 4;
    constexpr int nt = K / BK;
    unsigned voffB[2];
#pragma unroll
    for (int i = 0; i < 2; ++i) { int R, C; stage_rc(tid * 16 + i * 8192, R, C); const int Rb = PERM ? ((R & ~31) + perm32(R & 31)) : R; voffB[i] = (unsigned)(Rb * P.ldb + C) * 2u; }
    constexpr unsigned kstep = BK * 2;
    const unsigned hstepB = (unsigned)HALF * P.ldb * 2;
    const unsigned ldsw = (unsigned)wid * 1024u;
    const int aoff = lds_byte(wr * 64 + fr, fq * 8), boff = lds_byte(wc * 32 + fr, fq * 8);
#define PG8_SA(b, h) (((b) * 2 + (h)) * HTB)
#define PG8_SB(b, h) ((4 + (b) * 2 + (h)) * HTB)
#define PG8_STAGE_B(bufoff, sboff) do { _Pragma("unroll") for (int _i = 0; _i < 2; ++_i) \
        __builtin_amdgcn_global_load_lds((const unsigned*)(base + (size_t)(unsigned)((sboff) + voffB[_i])), (LAS unsigned*)(lds + (bufoff) + ldsw + _i * 8192), 16, 0, 0); } while (0)
#define PG8_STAGE_A(bufoff, v32, kb) do { _Pragma("unroll") for (int _i = 0; _i < 2; ++_i) \
        __builtin_amdgcn_global_load_lds((const unsigned*)(base + (size_t)(unsigned)((v32) + (kb))), (LAS unsigned*)(lds + (bufoff) + ldsw + _i * 8192), 16, 0, 0); } while (0)
#define PG8_LSTAGE_B(bufoff, sboff) do { if ((ABL & 2) == 0) PG8_STAGE_B(bufoff, sboff); } while (0)
#define PG8_LSTAGE_A(bufoff, v32, kb) do { if ((ABL & 2) == 0) PG8_STAGE_A(bufoff, v32, kb); } while (0)
#define PG8_LDA(dst, b, h) do { _Pragma("unroll") for (int m = 0; m < 4; ++m) { const i32x4v _lo = *(const LAS i32x4v*)(lds + PG8_SA(b, h) + aoff + m * 2048), _hi = *(const LAS i32x4v*)(lds + PG8_SA(b, h) + aoff + m * 2048 + 1024); dst[m] = __builtin_shufflevector(_lo, _hi, 0, 1, 2, 3, 4, 5, 6, 7); } } while (0)
#define PG8_LDB(dst, b, h) do { _Pragma("unroll") for (int n = 0; n < 2; ++n) { const i32x4v _lo = *(const LAS i32x4v*)(lds + PG8_SB(b, h) + boff + n * 2048), _hi = *(const LAS i32x4v*)(lds + PG8_SB(b, h) + boff + n * 2048 + 1024); dst[n] = __builtin_shufflevector(_lo, _hi, 0, 1, 2, 3, 4, 5, 6, 7); } } while (0)
#define PG8_MMA(ai, bj, At, Bt) do { __builtin_amdgcn_s_setprio(1); if (F8) { \
        _Pragma("unroll") for (int m = 0; m < 4; ++m) _Pragma("unroll") for (int n = 0; n < 2; ++n) \
            { if ((ABL & 1) == 0) acc[ai][bj][m][n] = __builtin_amdgcn_mfma_scale_f32_16x16x128_f8f6f4(Bt[n], At[m], acc[ai][bj][m][n], 0, 0, 0, 0, 0, 0); else asm volatile("" :: "v"(Bt[n]), "v"(At[m])); } \
      } else { _Pragma("unroll") for (int m = 0; m < 4; ++m) _Pragma("unroll") for (int n = 0; n < 2; ++n) { \
            const bf16x8 _a0 = (bf16x8)__builtin_shufflevector(At[m], At[m], 0, 1, 2, 3), _a1 = (bf16x8)__builtin_shufflevector(At[m], At[m], 4, 5, 6, 7); \
            const bf16x8 _b0 = (bf16x8)__builtin_shufflevector(Bt[n], Bt[n], 0, 1, 2, 3), _b1 = (bf16x8)__builtin_shufflevector(Bt[n], Bt[n], 4, 5, 6, 7); \
            if ((ABL & 1) == 0) { acc[ai][bj][m][n] = __builtin_amdgcn_mfma_f32_16x16x32_bf16(_b0, _a0, acc[ai][bj][m][n], 0, 0, 0); acc[ai][bj][m][n] = __builtin_amdgcn_mfma_f32_16x16x32_bf16(_b1, _a1, acc[ai][bj][m][n], 0, 0, 0); } \
            else asm volatile("" :: "v"(Bt[n]), "v"(At[m])); } } __builtin_amdgcn_s_setprio(0); } while (0)
#define PG8_WAIT_V(n) asm volatile("s_waitcnt vmcnt(" #n ")" ::: "memory")
#define PG8_WAIT_L(n) asm volatile("s_waitcnt lgkmcnt(" #n ")" ::: "memory")
#define PG8_BAR __builtin_amdgcn_s_barrier()
#define PG8_SCHED __builtin_amdgcn_sched_barrier(0)
    Unit cur, nxt; int ui = 0;
    cur.e = 0;
    if (!P.unit(vid, cur)) return;
    const int rot = P.rot(vid) & (nt - 1);
#define PG8_KB(i) ((unsigned)((rot + (i)) & (nt - 1)) * kstep)
    f32x4 acc[2][2][4][2];
#pragma unroll
    for (int a = 0; a < 2; ++a)
#pragma unroll
        for (int b = 0; b < 2; ++b)
#pragma unroll
            for (int m = 0; m < 4; ++m)
#pragma unroll
                for (int n = 0; n < 2; ++n) acc[a][b][m][n] = (f32x4){0.f, 0.f, 0.f, 0.f};
    i32x8 At[4], B0[2], B1[2];
    unsigned vA[2][2];
    P.aoff_first(cur, tid, vA);
    unsigned cB = P.bbase(cur);
    { const unsigned k0 = PG8_KB(0);
    PG8_STAGE_B(PG8_SB(0, 0), cB + k0); PG8_STAGE_B(PG8_SB(0, 1), cB + hstepB + k0); PG8_STAGE_A(PG8_SA(0, 0), vA[0][_i], k0); PG8_STAGE_A(PG8_SA(0, 1), vA[1][_i], k0); }
    if (wr == 1) PG8_BAR;
    PG8_WAIT_V(2); PG8_BAR;
    { const unsigned k1p = PG8_KB(1);
    PG8_STAGE_B(PG8_SB(1, 0), cB + k1p); PG8_STAGE_A(PG8_SA(1, 0), vA[0][_i], k1p); PG8_STAGE_B(PG8_SB(1, 1), cB + hstepB + k1p); }
    PG8_WAIT_V(6); PG8_BAR;
    for (;;) {
        nxt.e = cur.e;
        const bool has_next = P.unit((ui + 1) * G + vid, nxt);
        const unsigned nB = has_next ? P.bbase(nxt) : cB;
#pragma unroll 1
        for (int t = 0; t < nt; t += 2) {
            const bool last = (t == nt - 2);
            if (t == 0) { const int lane2 = my_tid(wvi) & 63; P.prefetch(cur, nxt, has_next, ui, wid, lane2, lds); }
            const unsigned k1 = PG8_KB(t + 1);
            const unsigned k2 = PG8_KB(t + 2), k3 = PG8_KB(t + 3);
            const unsigned b2 = (last ? nB : cB) + k2, b3 = (last ? nB : cB) + k3;
            PG8_LDB(B0, 0, 0); PG8_LDB(B1, 0, 1); PG8_SCHED; PG8_LDA(At, 0, 0); PG8_LSTAGE_A(PG8_SA(1, 1), vA[1][_i], k1);
            PG8_WAIT_V(8); PG8_WAIT_L(0); PG8_BAR; PG8_MMA(0, 0, At, B0); PG8_MMA(0, 1, At, B1); PG8_BAR; PG8_SCHED;
            if (last && has_next) { const int tid2 = my_tid(wvi); P.aoff_next(nxt, tid2, vA, lds); }
            PG8_LDA(At, 0, 1); PG8_LSTAGE_B(PG8_SB(0, 0), b2); PG8_LSTAGE_B(PG8_SB(0, 1), b2 + hstepB); PG8_LSTAGE_A(PG8_SA(0, 0), vA[0][_i], k2);
            PG8_WAIT_V(8); PG8_WAIT_L(0); PG8_BAR; PG8_MMA(1, 0, At, B0); PG8_MMA(1, 1, At, B1); PG8_BAR; PG8_SCHED;
            PG8_LDB(B0, 1, 0); PG8_LDB(B1, 1, 1); PG8_SCHED; PG8_LDA(At, 1, 0); PG8_LSTAGE_A(PG8_SA(0, 1), vA[1][_i], k2);
            PG8_WAIT_V(8); PG8_WAIT_L(0); PG8_BAR; PG8_MMA(0, 0, At, B0); PG8_MMA(0, 1, At, B1); PG8_BAR; PG8_SCHED;
            PG8_LDA(At, 1, 1); PG8_LSTAGE_B(PG8_SB(1, 0), b3); PG8_LSTAGE_B(PG8_SB(1, 1), b3 + hstepB); PG8_LSTAGE_A(PG8_SA(1, 0), vA[0][_i], k3);
            PG8_WAIT_V(8); PG8_WAIT_L(0); PG8_BAR; PG8_MMA(1, 0, At, B0); PG8_MMA(1, 1, At, B1); PG8_BAR; PG8_SCHED;
        }
        if (wr == 0) PG8_BAR;
        if ((ABL & 64) == 0) { int fr2 = fr, fq2 = fq; asm volatile("" : "+v"(fr2), "+v"(fq2)); P.epi(acc, cur, wr, wc, fr2, fq2, lds, ui); } else { _Pragma("unroll") for (int a = 0; a < 2; ++a) _Pragma("unroll") for (int b = 0; b < 2; ++b) _Pragma("unroll") for (int m = 0; m < 4; ++m) _Pragma("unroll") for (int n = 0; n < 2; ++n) asm volatile("" :: "v"(acc[a][b][m][n])); }
        if (!has_next) break;
#pragma unroll
        for (int a = 0; a < 2; ++a)
#pragma unroll
            for (int b = 0; b < 2; ++b)
#pragma unroll
                for (int m = 0; m < 4; ++m)
#pragma unroll
                    for (int n = 0; n < 2; ++n) acc[a][b][m][n] = (f32x4){0.f, 0.f, 0.f, 0.f};
        cur = nxt; cB = nB; ++ui;
        if (wr == 1) PG8_BAR;
    }
    PG8_WAIT_V(0);
    PG8_BAR;
}

template <int K, bool PERM, bool F8, bool MID = false, class Prob>
__device__ __forceinline__ void gemm_phase_p(LAS unsigned char* lds, const char* base, const Prob& P, const int vid, const int G, const int wvi) {
    constexpr int ABL = 0;
    const int tid = my_tid(wvi), wid = __builtin_amdgcn_readfirstlane(tid >> 6), lane = tid & 63, wr = wid >> 2, wc = wid & 3, fr = lane & 15, fq = lane >> 4;
    constexpr int nt = K / BK;
    static_assert(nt >= 4 && (nt & 1) == 0, "K tiles");
    unsigned voffB0;
    { int R, C; stage_rc(tid * 16, R, C); const int Rb = PERM ? ((R & ~31) + perm32(R & 31)) : R; voffB0 = (unsigned)(Rb * P.ldb + C) * 2u; }
    const unsigned istepB = 64u * (unsigned)P.ldb * 2u;
    constexpr unsigned kstep = BK * 2;
    const unsigned hstepB = (unsigned)HALF * P.ldb * 2;
    const unsigned ldsw = (unsigned)wid * 1024u;
    unsigned aaddr, baddr;
#define PP_STAGE_B(bufoff, sboff) do { _Pragma("unroll") for (int _i = 0; _i < 2; ++_i) \
        __builtin_amdgcn_global_load_lds((const unsigned*)(base + (size_t)(unsigned)((sboff) + _i * istepB)), (LAS unsigned*)(lds + (bufoff) + ldsw + _i * 8192), 16, 0, 0); } while (0)
#define PP_AV(h, i) (Prob::GATHER ? vA[h][i] : (vA[0][0] + (unsigned)(h) * hstepA + (unsigned)(i) * istepA))
#define PP_STAGE_A(bufoff, h, kb) do { _Pragma("unroll") for (int _i = 0; _i < 2; ++_i) \
        __builtin_amdgcn_global_load_lds((const unsigned*)(base + (size_t)(unsigned)(PP_AV(h, _i) + (kb))), (LAS unsigned*)(lds + (bufoff) + ldsw + _i * 8192), 16, 0, 0); } while (0)
    const unsigned istepA = 64u * (unsigned)P.lda * 2u, hstepA = 2u * istepA;
    Unit cur, nxt; int ui = 0;
    cur.e = 0;
    if (!P.unit(vid, cur)) return;
    f32x4 acc[2][2][4][2];
#pragma unroll
    for (int a = 0; a < 2; ++a)
#pragma unroll
        for (int b = 0; b < 2; ++b)
#pragma unroll
            for (int m = 0; m < 4; ++m)
#pragma unroll
                for (int n = 0; n < 2; ++n) acc[a][b][m][n] = (f32x4){0.f, 0.f, 0.f, 0.f};
    i32x8 Q0, Q1, B0[2], B1[2];
    unsigned vA[2][2];
    P.aoff_first(cur, tid, vA);
    unsigned cB = P.bbase(cur) + voffB0;
    PP_STAGE_B(PG8_SB(0, 0), cB); PP_STAGE_B(PG8_SB(0, 1), cB + hstepB); PP_STAGE_A(PG8_SA(0, 0), 0, 0u); PP_STAGE_A(PG8_SA(0, 1), 1, 0u);
    PP_STAGE_B(PG8_SB(1, 0), cB + kstep); PP_STAGE_B(PG8_SB(1, 1), cB + hstepB + kstep); PP_STAGE_A(PG8_SA(1, 0), 0, kstep); PP_STAGE_A(PG8_SA(1, 1), 1, kstep);
    PG8_WAIT_V(8); PG8_BAR;
#define PG8_DSR(lo, hi, addr, off) asm volatile("ds_read_b128 %0, %2 offset:%3\n\tds_read_b128 %1, %2 offset:%4" : "=&v"(lo), "=&v"(hi) : "v"(addr), "n"(off), "n"((off) + 1024) : "memory")
#define PG8_LDQ(dst, b, r) do { i32x4v _lo, _hi; PG8_DSR(_lo, _hi, aaddr, PG8_SA(b, (r) >> 2) + ((r) & 3) * 2048); dst = __builtin_shufflevector(_lo, _hi, 0, 1, 2, 3, 4, 5, 6, 7); } while (0)
#define PG8_LDBQ(dst, b, h) do { i32x4v _lo, _hi; PG8_DSR(_lo, _hi, baddr, PG8_SB(b, h) - 65536); dst[0] = __builtin_shufflevector(_lo, _hi, 0, 1, 2, 3, 4, 5, 6, 7); \
                                 i32x4v _l2, _h2; PG8_DSR(_l2, _h2, baddr, PG8_SB(b, h) - 65536 + 2048); dst[1] = __builtin_shufflevector(_l2, _h2, 0, 1, 2, 3, 4, 5, 6, 7); } while (0)
#define PG8_WQ1(n, x) asm volatile("s_waitcnt lgkmcnt(" #n ")" : "+v"(x) :: "memory")
#define PG8_WQ2(n, x, y) asm volatile("s_waitcnt lgkmcnt(" #n ")" : "+v"(x), "+v"(y) :: "memory")
#define PG8_WQ3(n, x, y, z) asm volatile("s_waitcnt lgkmcnt(" #n ")" : "+v"(x), "+v"(y), "+v"(z) :: "memory")
#define PG8_SUBQ(r, bj, Aq, Bt) do { __builtin_amdgcn_s_setprio(1); _Pragma("unroll") for (int n = 0; n < 2; ++n) { \
        f32x4& _c = acc[(r) >> 2][bj][(r) & 3][n]; \
        if (F8) _c = __builtin_amdgcn_mfma_scale_f32_16x16x128_f8f6f4(Bt[n], Aq, _c, 0, 0, 0, 0, 0, 0); \
        else { _c = __builtin_amdgcn_mfma_f32_16x16x32_bf16((bf16x8)__builtin_shufflevector(Bt[n], Bt[n], 0, 1, 2, 3), (bf16x8)__builtin_shufflevector(Aq, Aq, 0, 1, 2, 3), _c, 0, 0, 0); \
               _c = __builtin_amdgcn_mfma_f32_16x16x32_bf16((bf16x8)__builtin_shufflevector(Bt[n], Bt[n], 4, 5, 6, 7), (bf16x8)__builtin_shufflevector(Aq, Aq, 4, 5, 6, 7), _c, 0, 0, 0); } } \
        __builtin_amdgcn_s_setprio(0); PG8_SCHED; } while (0)
#define PG8_ROW(r, Aq) do { PG8_SUBQ(r, 0, Aq, B0); PG8_SUBQ(r, 1, Aq, B1); } while (0)
#define PG8_TILE_E(b, tt, WRAP, PREF) do { \
        PG8_LDQ(Q1, b, 1); PG8_WQ3(6, Q0, B0[0], B0[1]); PG8_SUBQ(0, 0, Q0, B0); PG8_WQ2(2, B1[0], B1[1]); PG8_SUBQ(0, 1, Q0, B1); \
        PG8_LDQ(Q0, b, 2); PG8_WQ1(2, Q1); PG8_ROW(1, Q1); \
        PG8_LDQ(Q1, b, 3); PG8_WQ1(2, Q0); PG8_ROW(2, Q0); \
        PG8_LDQ(Q0, b, 4); PG8_WQ1(2, Q1); PG8_ROW(3, Q1); \
        PG8_LDQ(Q1, b, 5); PG8_WQ1(2, Q0); PG8_ROW(4, Q0); \
        PG8_LDQ(Q0, b, 6); PG8_WQ1(2, Q1); PG8_ROW(5, Q1); \
        PG8_LDQ(Q1, b, 7); PG8_WQ1(2, Q0); PG8_SUBQ(6, 0, Q0, B0); \
        PG8_WQ1(0, Q1); PG8_WAIT_V(0); \
        PG8_BAR; \
        { const unsigned _kk = (unsigned)((WRAP) ? (tt) + 2 - nt : (tt) + 2) * kstep; const unsigned _bb = ((WRAP) ? nB : cB) + _kk;     \
          PP_STAGE_B(PG8_SB(b, 0), _bb); \
          PG8_SUBQ(7, 0, Q1, B0); \
          if (PREF) PG8_LDBQ(B0, (b) ^ 1, 0); \
          PP_STAGE_B(PG8_SB(b, 1), _bb + hstepB); \
          PG8_SUBQ(6, 1, Q0, B1); \
          if (PREF) PG8_LDQ(Q0, (b) ^ 1, 0); \
          PP_STAGE_A(PG8_SA(b, 0), 0, _kk); \
          PG8_SUBQ(7, 1, Q1, B1); \
          if (PREF) PG8_LDBQ(B1, (b) ^ 1, 1); \
          PP_STAGE_A(PG8_SA(b, 1), 1, _kk); } \
    } while (0)
#define PG8_TILE_M(b, tt, WRAP, PREF) do { \
        const unsigned _kk = (unsigned)((WRAP) ? (tt) + 2 - nt : (tt) + 2) * kstep; const unsigned _bb = ((WRAP) ? nB : cB) + _kk; \
        PG8_LDQ(Q1, b, 1); PG8_WQ3(6, Q0, B0[0], B0[1]); PG8_SUBQ(0, 0, Q0, B0); PG8_WQ2(2, B1[0], B1[1]); PG8_SUBQ(0, 1, Q0, B1); \
        PG8_LDQ(Q0, b, 2); PG8_WQ1(2, Q1); PG8_ROW(1, Q1); \
        PG8_LDQ(Q1, b, 3); PG8_WQ1(2, Q0); PG8_ROW(2, Q0); \
        PG8_LDQ(Q0, b, 4); PG8_WQ1(2, Q1); \
        PG8_BAR; \
        PP_STAGE_B(PG8_SB(b, 0), _bb); \
        PG8_SUBQ(3, 0, Q1, B0); \
        PP_STAGE_B(PG8_SB(b, 1), _bb + hstepB); \
        PG8_SUBQ(3, 1, Q1, B1); \
        PP_STAGE_A(PG8_SA(b, 0), 0, _kk); \
        PG8_LDQ(Q1, b, 5); PG8_WQ1(2, Q0); PG8_ROW(4, Q0); \
        PG8_LDQ(Q0, b, 6); PG8_WQ1(2, Q1); PG8_ROW(5, Q1); \
        PG8_LDQ(Q1, b, 7); PG8_WQ1(2, Q0); PG8_SUBQ(6, 0, Q0, B0); \
        PG8_WQ1(0, Q1); PG8_WAIT_V(6); \
        PG8_BAR; \
        PP_STAGE_A(PG8_SA(b, 1), 1, _kk); \
        PG8_SUBQ(7, 0, Q1, B0); \
        if (PREF) PG8_LDBQ(B0, (b) ^ 1, 0); \
        PG8_SUBQ(6, 1, Q0, B1); \
        if (PREF) PG8_LDQ(Q0, (b) ^ 1, 0); \
        PG8_SUBQ(7, 1, Q1, B1); \
        if (PREF) PG8_LDBQ(B1, (b) ^ 1, 1); \
    } while (0)
#define PG8_TILE(b, tt, WRAP, PREF) do { if (MID) PG8_TILE_M(b, tt, WRAP, PREF); else PG8_TILE_E(b, tt, WRAP, PREF); } while (0)
    for (;;) {
        unsigned nB = cB;
        { const int lane2 = my_tid(wvi) & 63;
          aaddr = (unsigned)(__UINTPTR_TYPE__)lds + (unsigned)lds_byte(wr * 64 + (lane2 & 15), (lane2 >> 4) * 8); baddr = (unsigned)(__UINTPTR_TYPE__)lds + 65536u + (unsigned)lds_byte(wc * 32 + (lane2 & 15), (lane2 >> 4) * 8); }
        PG8_LDBQ(B0, 0, 0); PG8_LDQ(Q0, 0, 0); PG8_LDBQ(B1, 0, 1);
        PG8_TILE(0, 0, false, true);
        nxt.e = cur.e;
        const bool has_next = P.unit((ui + 1) * G + vid, nxt);
        { const int lane3 = my_tid(wvi) & 63; P.prefetch(cur, nxt, has_next, ui, wid, lane3, lds); }
#pragma unroll 1
        for (int t = 1; t + 1 <= nt - 3; t += 2) { PG8_TILE(1, t, false, true); PG8_TILE(0, t + 1, false, true); }
        PG8_TILE(1, nt - 3, false, true);
        { unsigned vN[2][2]; const int tid2 = my_tid(wvi); P.aoff_next(nxt, tid2, vN, lds);
          { int R, C; stage_rc(tid2 * 16, R, C); const int Rb = PERM ? ((R & ~31) + perm32(R & 31)) : R; const unsigned _nb = P.bbase(nxt) + (unsigned)(Rb * P.ldb + C) * 2u; nB = has_next ? _nb : cB; asm volatile("" : "+v"(nB)); }
#pragma unroll
          for (int h = 0; h < 2; ++h)
#pragma unroll
              for (int i = 0; i < 2; ++i) if (Prob::GATHER || (h == 0 && i == 0)) { unsigned _s = has_next ? vN[h][i] : vA[h][i]; asm volatile("" : "+v"(_s)); vA[h][i] = _s; } }
        PG8_TILE(0, nt - 2, true, true);
        PG8_TILE(1, nt - 1, true, false);
        { const int l2 = my_tid(wvi) & 63; P.epi(acc, cur, wr, wc, l2 & 15, l2 >> 4, lds, ui); }
        if (!has_next) break;
#pragma unroll
        for (int a = 0; a < 2; ++a)
#pragma unroll
            for (int b = 0; b < 2; ++b)
#pragma unroll
                for (int m = 0; m < 4; ++m)
#pragma unroll
                    for (int n = 0; n < 2; ++n) acc[a][b][m][n] = (f32x4){0.f, 0.f, 0.f, 0.f};
        cur = nxt; cB = nB; ++ui;
    }
    PG8_WAIT_V(0);
    PG8_BAR;
#undef PG8_TILE
#undef PG8_TILE_E
#undef PG8_TILE_M
#undef PP_STAGE_A
#undef PP_STAGE_B
#undef PP_AV
#undef PG8_DSR
#undef PG8_LDBQ
#undef PG8_WQ1
#undef PG8_WQ2
#undef PG8_WQ3
#undef PG8_SUBQ
#undef PG8_ROW
#undef PG8_LDQ
}
#undef PG8_KB
#undef PG8_SA
#undef PG8_SB
#undef PG8_STAGE_A
#undef PG8_STAGE_B
#undef PG8_LSTAGE_A
#undef PG8_LSTAGE_B
#undef PG8_LDA
#undef PG8_LDB
#undef PG8_MMA
#undef PG8_WAIT_V
#undef PG8_WAIT_L
#undef PG8_BAR
#undef PG8_SCHED
}
using pg8::Unit;
typedef f32x4 AccT[2][2][4][2];

struct ProbPool {
    static constexpr bool GATHER = false; static constexpr int lda = 1024;
    unsigned A; int ldb; unsigned Bt; bf16_t* Z;
    __device__ __forceinline__ int rot(int v) const { return 0; }
    __device__ __forceinline__ bool unit(int L, Unit& u) const { if (L >= 136 * 4) return false; u.pm = L >> 2; u.pn = L & 3; u.e = 0; u.aux = 0; return true; }
    __device__ __forceinline__ void aoff_next(const Unit& u, const int tid, unsigned (&v)[2][2], LAS unsigned char*) const { aoff_first(u, tid, v); }
    __device__ __forceinline__ void prefetch(const Unit&, const Unit&, bool, int, int, int, LAS unsigned char*) const {}
    __device__ __forceinline__ void aoff_first(const Unit& u, const int tid, unsigned (&v)[2][2]) const {
        int Ra[2], Ca[2]; pg8::stage_rc(tid * 16, Ra[0], Ca[0]); pg8::stage_rc(tid * 16 + 8192, Ra[1], Ca[1]);
#pragma unroll
        for (int h = 0; h < 2; ++h)
#pragma unroll
            for (int i = 0; i < 2; ++i) v[h][i] = A + (unsigned)((u.pm * 256 + h * 128 + Ra[i]) * 1024 + u.pn * 256 + Ca[i]) * 2u;
    }
    __device__ __forceinline__ unsigned bbase(const Unit& u) const { return Bt + (unsigned)u.pn * (256u * 256u * 2u); }
    __device__ __forceinline__ void epi(const AccT& acc, const Unit& u, int wr, int wc, int fr, int fq, LAS unsigned char* lds, int ui) const {
#pragma unroll
        for (int ai = 0; ai < 2; ++ai)
#pragma unroll
            for (int m = 0; m < 4; ++m) {
                const int row = u.pm * 256 + ai * 128 + wr * 64 + m * 16 + fr;
                bf16_t* rp = Z + (size_t)row * 1024 + u.pn * 256 + wc * 32 + fq * 8;
#pragma unroll
                for (int bj = 0; bj < 2; ++bj) { const f32x4 v0 = acc[ai][bj][m][0], v1 = acc[ai][bj][m][1];
                    u32x4 w; w.x = cvt_pk_bf16(v0[0], v0[1]); w.y = cvt_pk_bf16(v0[2], v0[3]); w.z = cvt_pk_bf16(v1[0], v1[1]); w.w = cvt_pk_bf16(v1[2], v1[3]);
                    *(u32x4*)(rp + bj * 128) = w; }
            }
    }
};

__device__ __forceinline__ void moe_table(LAS int* tab, const int* counts, const int wvi) {
    const int tid = my_tid(wvi);
    if (tid < 32) tab[40 + tid] = counts[tid];
    __syncthreads();
    if (tid < 33) { int s = 0; for (int e = 0; e < tid; ++e) s += (tab[40 + e] + 255) >> 8; tab[tid] = s; }
    __syncthreads();
}

struct ProbMoe1 {
    static constexpr bool GATHER = true; static constexpr int lda = 512;
    unsigned A; int ldb; unsigned Bt; LAS const int* tab; const int* list; const float* bgu; bf16_t* ACT;
    __device__ __forceinline__ int rot(int v) const { return 0; }
    __device__ __forceinline__ bool unit(int L, Unit& u) const {
        const int mt = L >> 3; if (mt >= tab[32]) return false;
        int e = u.e; if ((unsigned)e > 31u || tab[e] > mt) e = 0;
        while (tab[e + 1] <= mt) ++e;
        e = __builtin_amdgcn_readfirstlane(e);
        u.e = e; u.pn = L & 7; u.pm = __builtin_amdgcn_readfirstlane(mt - tab[e]); u.aux = __builtin_amdgcn_readfirstlane(mt * 256); return true;
    }
    __device__ __forceinline__ void aoff_first(const Unit& u, const int tid, unsigned (&v)[2][2]) const {
        int Ra[2], Ca[2]; pg8::stage_rc(tid * 16, Ra[0], Ca[0]); pg8::stage_rc(tid * 16 + 8192, Ra[1], Ca[1]);
        const int cnt = tab[40 + u.e];
#pragma unroll
        for (int h = 0; h < 2; ++h)
#pragma unroll
            for (int i = 0; i < 2; ++i) { const int r = u.pm * 256 + h * 128 + Ra[i]; const int tok = list[u.e * NT0 + min(r, cnt - 1)]; v[h][i] = A + (unsigned)tok * 1024u + (unsigned)Ca[i] * 2u; }
    }
    __device__ __forceinline__ void aoff_next(const Unit& u, const int tid, unsigned (&v)[2][2], LAS unsigned char* lds) const {
        int Ra[2], Ca[2]; pg8::stage_rc(tid * 16, Ra[0], Ca[0]); pg8::stage_rc(tid * 16 + 8192, Ra[1], Ca[1]);
        const LAS int* idt = (const LAS int*)(lds + IDTAB);
#pragma unroll
        for (int h = 0; h < 2; ++h)
#pragma unroll
            for (int i = 0; i < 2; ++i) { const int tok = idt[h * 128 + Ra[i]]; v[h][i] = A + (unsigned)tok * 1024u + (unsigned)Ca[i] * 2u; }
    }
    __device__ __forceinline__ void prefetch(const Unit& cur, const Unit& nxt, bool has_next, int ui, int wid, int lane, LAS unsigned char* lds) const {
        if (wid < 4) {
            if (has_next) { const int cnt = tab[40 + nxt.e]; const int r = nxt.pm * 256 + wid * 64 + lane;
                __builtin_amdgcn_global_load_lds((const unsigned*)(list + (size_t)nxt.e * NT0 + min(r, cnt - 1)), (LAS unsigned*)(lds + IDTAB + wid * 256), 4, 0, 0); }
        } else { const int w = wid - 4;
            __builtin_amdgcn_global_load_lds((const unsigned*)(bgu + (size_t)cur.e * 2048 + (w >> 1) * 1024 + cur.pn * 128 + (w & 1) * 64 + lane), (LAS unsigned*)(lds + BIASTAB + (ui & 1) * 1024 + w * 256), 4, 0, 0); }
    }
    __device__ __forceinline__ unsigned bbase(const Unit& u) const { return Bt + ((unsigned)u.e * 2048u + (unsigned)u.pn * 256u) * 1024u; }
    __device__ __forceinline__ void epi(const AccT& acc, const Unit& u, int wr, int wc, int fr, int fq, LAS unsigned char* lds, int ui) const {
        const int j0 = u.pn * 128 + wc * 32 + fq * 8;
        const LAS float* bg = (const LAS float*)(lds + BIASTAB + (ui & 1) * 1024) + wc * 32 + fq * 8;
        const f32x4 bg0 = *(const LAS f32x4*)(bg), bg1 = *(const LAS f32x4*)(bg + 4), bu0 = *(const LAS f32x4*)(bg + 128), bu1 = *(const LAS f32x4*)(bg + 132);
#pragma unroll
        for (int ai = 0; ai < 2; ++ai)
#pragma unroll
            for (int m = 0; m < 4; ++m) {
                const int slot = u.aux + ai * 128 + wr * 64 + m * 16 + fr;
                const f32x4 g0 = acc[ai][0][m][0] * 0.015625f + bg0, g1 = acc[ai][0][m][1] * 0.015625f + bg1, u0 = acc[ai][1][m][0] * 0.015625f + bu0, u1 = acc[ai][1][m][1] * 0.015625f + bu1;
                float o[8];
#pragma unroll
                for (int c2 = 0; c2 < 4; ++c2) {
                    const f32x4 gs = c2 < 2 ? g0 : g1, us = c2 < 2 ? u0 : u1; const int h = (c2 & 1) * 2;
                    f32x2 g = (f32x2){fminf(gs[h], 7.0f), fminf(gs[h + 1], 7.0f)}, uu = (f32x2){fminf(fmaxf(us[h], -7.0f), 7.0f), fminf(fmaxf(us[h + 1], -7.0f), 7.0f)};
                    const f32x2 t = g * (f32x2){-1.702f * 1.44269504089f, -1.702f * 1.44269504089f};
                    const f32x2 d = (f32x2){ex2(t[0]), ex2(t[1])} + (f32x2){1.0f, 1.0f};
                    const f32x2 r = (f32x2){fast_rcp(d[0]), fast_rcp(d[1])};
                    const f32x2 ov = (uu + (f32x2){1.0f, 1.0f}) * g * r;
                    o[2 * c2] = ov[0]; o[2 * c2 + 1] = ov[1];
                }
                u32x2 w; w.x = pack4_fp8((f32x4){o[0], o[1], o[2], o[3]}); w.y = pack4_fp8((f32x4){o[4], o[5], o[6], o[7]});
                *(u32x2*)((unsigned char*)ACT + (size_t)slot * 1024 + j0) = w;
            }
    }
};

struct ProbMoe2 {
    static constexpr bool GATHER = false; static constexpr int lda = 512;
    unsigned A; int ldb; unsigned Bt; LAS const int* tab; const float* bdn; bf16_t* OUTB;
    __device__ __forceinline__ int rot(int v) const { return 0; }
    __device__ __forceinline__ bool unit(int L, Unit& u) const {
        const int mt = L >> 2; if (mt >= tab[32]) return false;
        int e = u.e; if ((unsigned)e > 31u || tab[e] > mt) e = 0;
        while (tab[e + 1] <= mt) ++e;
        e = __builtin_amdgcn_readfirstlane(e);
        u.e = e; u.pn = L & 3; u.pm = 0; u.aux = __builtin_amdgcn_readfirstlane(mt * 256); return true;
    }
    __device__ __forceinline__ void aoff_first(const Unit& u, const int tid, unsigned (&v)[2][2]) const {
        int Ra[2], Ca[2]; pg8::stage_rc(tid * 16, Ra[0], Ca[0]); pg8::stage_rc(tid * 16 + 8192, Ra[1], Ca[1]);
#pragma unroll
        for (int h = 0; h < 2; ++h)
#pragma unroll
            for (int i = 0; i < 2; ++i) v[h][i] = A + (unsigned)(u.aux + h * 128 + Ra[i]) * 1024u + (unsigned)Ca[i] * 2u;
    }
    __device__ __forceinline__ void aoff_next(const Unit& u, const int tid, unsigned (&v)[2][2], LAS unsigned char*) const { aoff_first(u, tid, v); }
    __device__ __forceinline__ void prefetch(const Unit& cur, const Unit&, bool, int ui, int wid, int lane, LAS unsigned char* lds) const {
        if (wid >= 4) { const int w = wid - 4;
            __builtin_amdgcn_global_load_lds((const unsigned*)(bdn + (size_t)cur.e * 1024 + cur.pn * 256 + w * 64 + lane), (LAS unsigned*)(lds + BIASTAB + (ui & 1) * 1024 + w * 256), 4, 0, 0); }
    }
    __device__ __forceinline__ unsigned bbase(const Unit& u) const { return Bt + ((unsigned)u.e * 1024u + (unsigned)u.pn * 256u) * 1024u; }
    __device__ __forceinline__ void epi(const AccT& acc, const Unit& u, int wr, int wc, int fr, int fq, LAS unsigned char* lds, int ui) const {
        const int c0 = u.pn * 256 + wc * 32 + fq * 8;
        const LAS float* bp = (const LAS float*)(lds + BIASTAB + (ui & 1) * 1024) + wc * 32 + fq * 8;
        f32x4 bv[2][2];
#pragma unroll
        for (int bj = 0; bj < 2; ++bj) { bv[bj][0] = *(const LAS f32x4*)(bp + bj * 128); bv[bj][1] = *(const LAS f32x4*)(bp + bj * 128 + 4); }
#pragma unroll
        for (int ai = 0; ai < 2; ++ai)
#pragma unroll
            for (int m = 0; m < 4; ++m) {
                const int slot = u.aux + ai * 128 + wr * 64 + m * 16 + fr;
                unsigned char* rp = (unsigned char*)OUTB + (size_t)slot * 1024 + c0;
#pragma unroll
                for (int bj = 0; bj < 2; ++bj) { f32x4 v0 = acc[ai][bj][m][0] * 0.25f + bv[bj][0] * 16.0f, v1 = acc[ai][bj][m][1] * 0.25f + bv[bj][1] * 16.0f;
#pragma unroll
                    for (int c = 0; c < 4; ++c) { v0[c] = fminf(fmaxf(v0[c], -448.0f), 448.0f); v1[c] = fminf(fmaxf(v1[c], -448.0f), 448.0f); }
                    u32x2 w; w.x = pack4_fp8(v0); w.y = pack4_fp8(v1);
                    *(u32x2*)(rp + bj * 128) = w; }
            }
    }
};

struct ProbIn {
    static constexpr bool GATHER = false; static constexpr int lda = 1024;
    unsigned A; int ldb; unsigned Bt; bf16_t* GATE; bf16_t* UPRE;
    __device__ __forceinline__ int rot(int v) const { return 0; }
    __device__ __forceinline__ bool unit(int L, Unit& u) const {
        if (L < 1024) { u.pm = L >> 3; u.pn = L & 7; } else { const int q = L - 1024; if (q >= 32) return false; u.pm = 128 + (q >> 2); u.pn = 4 + (q & 3); }
        u.e = 0; u.aux = 0; return true;
    }
    __device__ __forceinline__ void aoff_next(const Unit& u, const int tid, unsigned (&v)[2][2], LAS unsigned char*) const { aoff_first(u, tid, v); }
    __device__ __forceinline__ void prefetch(const Unit&, const Unit&, bool, int, int, int, LAS unsigned char*) const {}
    __device__ __forceinline__ void aoff_first(const Unit& u, const int tid, unsigned (&v)[2][2]) const {
        int Ra[2], Ca[2]; pg8::stage_rc(tid * 16, Ra[0], Ca[0]); pg8::stage_rc(tid * 16 + 8192, Ra[1], Ca[1]);
#pragma unroll
        for (int h = 0; h < 2; ++h)
#pragma unroll
            for (int i = 0; i < 2; ++i) v[h][i] = A + (unsigned)((u.pm * 256 + h * 128 + Ra[i]) * 1024 + Ca[i]) * 2u;
    }
    __device__ __forceinline__ unsigned bbase(const Unit& u) const { return Bt + (unsigned)u.pn * (256u * 1024u * 2u); }
    __device__ __forceinline__ void epi(const AccT& acc, const Unit& u, int wr, int wc, int fr, int fq, LAS unsigned char* lds, int ui) const {
        const bool isg = u.pn < 4;
        bf16_t* base = isg ? GATE : UPRE; const int c0 = (u.pn & 3) * 256 + wc * 32 + fq * 8;
#pragma unroll
        for (int ai = 0; ai < 2; ++ai)
#pragma unroll
            for (int m = 0; m < 4; ++m) {
                const int row = u.pm * 256 + ai * 128 + wr * 64 + m * 16 + fr;
                bf16_t* rp = base + (size_t)row * 1024 + c0;
#pragma unroll
                for (int bj = 0; bj < 2; ++bj) { f32x4 v0 = acc[ai][bj][m][0], v1 = acc[ai][bj][m][1];
                    if (isg) {
#pragma unroll
                        for (int c = 0; c < 4; ++c) { float x = v0[c]; v0[c] = x * sigmoidf_(1.5957691216f * (x + 0.044715f * x * x * x)); x = v1[c]; v1[c] = x * sigmoidf_(1.5957691216f * (x + 0.044715f * x * x * x)); }
                    }
                    if (!isg) {
                        v0 = v0 * 16.0f; v1 = v1 * 16.0f;
#pragma unroll
                        for (int c = 0; c < 4; ++c) { v0[c] = fminf(fmaxf(v0[c], -448.0f), 448.0f); v1[c] = fminf(fmaxf(v1[c], -448.0f), 448.0f); }
                        u32x2 w8; w8.x = pack4_fp8(v0); w8.y = pack4_fp8(v1);
                        *(u32x2*)((unsigned char*)UPRE + (size_t)row * 1024 + c0 + bj * 128) = w8;
                    } else {
                    u32x4 w; w.x = cvt_pk_bf16(v0[0], v0[1]); w.y = cvt_pk_bf16(v0[2], v0[3]); w.z = cvt_pk_bf16(v1[0], v1[1]); w.w = cvt_pk_bf16(v1[2], v1[3]);
                    *(u32x4*)(rp + bj * 128) = w; } }
            }
    }
};

struct ProbGate {
    static constexpr bool GATHER = false; static constexpr int lda = 1024;
    unsigned A; int ldb; unsigned Bt; const bf16_t* U; const float* br; const float* bi; const float* lam; bf16_t* LA; bf16_t* BBp;
    __device__ __forceinline__ int rot(int v) const { return 0; }
    __device__ __forceinline__ bool unit(int L, Unit& u) const { if (L >= 136 * 16) return false; u.pm = L >> 4; u.e = (L >> 2) & 3; u.pn = L & 3; u.aux = 0; return true; }
    __device__ __forceinline__ void aoff_next(const Unit& u, const int tid, unsigned (&v)[2][2], LAS unsigned char*) const { aoff_first(u, tid, v); }
    __device__ __forceinline__ void prefetch(const Unit&, const Unit&, bool, int, int, int, LAS unsigned char*) const {}
    __device__ __forceinline__ void aoff_first(const Unit& u, const int tid, unsigned (&v)[2][2]) const {
        int Ra[2], Ca[2]; pg8::stage_rc(tid * 16, Ra[0], Ca[0]); pg8::stage_rc(tid * 16 + 8192, Ra[1], Ca[1]);
#pragma unroll
        for (int h = 0; h < 2; ++h)
#pragma unroll
            for (int i = 0; i < 2; ++i) v[h][i] = A + (unsigned)((u.pm * 256 + h * 128 + Ra[i]) * 1024 + u.e * 256 + Ca[i]) * 2u;
    }
    __device__ __forceinline__ unsigned bbase(const Unit& u) const { return Bt + ((unsigned)u.e * 1024u + (unsigned)u.pn * 256u) * 512u; }
    __device__ __forceinline__ void epi(const AccT& acc, const Unit& u, int wr, int wc, int fr, int fq, LAS unsigned char* lds, int ui) const {
        const int d = u.pn >> 1, ch0 = u.e * 256 + (u.pn & 1) * 128 + wc * 32 + fq * 8;
        f32x4 brv[2], biv[2], sp[2];
#pragma unroll
        for (int n = 0; n < 2; ++n) { brv[n] = *(const f32x4*)(br + d * 1024 + ch0 + 4 * n); biv[n] = *(const f32x4*)(bi + d * 1024 + ch0 + 4 * n); sp[n] = *(const f32x4*)(lam + d * 1024 + ch0 + 4 * n); }
#pragma unroll
        for (int ai = 0; ai < 2; ++ai) {
            u32x4 uraw[4];
#pragma unroll
            for (int m = 0; m < 4; ++m) uraw[m] = *(const u32x4*)(U + (size_t)(u.pm * 256 + ai * 128 + wr * 64 + m * 16 + fr) * 1024 + ch0);
#pragma unroll
            for (int m = 0; m < 4; ++m) {
                const int row = u.pm * 256 + ai * 128 + wr * 64 + m * 16 + fr;
                const u32x4 ur = uraw[m];
                const f32x4 uu[2] = {(f32x4){bf_lo(ur.x), bf_hi(ur.x), bf_lo(ur.y), bf_hi(ur.y)}, (f32x4){bf_lo(ur.z), bf_hi(ur.z), bf_lo(ur.w), bf_hi(ur.w)}};
                float la[8], bb[8];
#pragma unroll
                for (int n = 0; n < 2; ++n) {
                    const f32x4 pr = acc[ai][0][m][n] + brv[n], pi = acc[ai][1][m][n] + biv[n];
#pragma unroll
                    for (int h = 0; h < 4; h += 2) {
                        const f32x2 one = (f32x2){1.0f, 1.0f}, nl2e = (f32x2){-1.44269504089f, -1.44269504089f};
                        const f32x2 tr = (f32x2){pr[h], pr[h + 1]} * nl2e, ti = (f32x2){pi[h], pi[h + 1]} * nl2e;
                        const f32x2 dr = (f32x2){ex2(tr[0]), ex2(tr[1])} + one, di = (f32x2){ex2(ti[0]), ex2(ti[1])} + one;
                        const f32x2 r = (f32x2){fast_rcp(dr[0]), fast_rcp(dr[1])}, ig = (f32x2){fast_rcp(di[0]), fast_rcp(di[1])};
                        const f32x2 l2 = -r * (f32x2){sp[n][h], sp[n][h + 1]}, t2 = l2 + l2;
                        const f32x2 om = one - (f32x2){ex2(t2[0]), ex2(t2[1])};
                        const f32x2 sq = (f32x2){__builtin_amdgcn_sqrtf(fmaxf(om[0], 0.0f)), __builtin_amdgcn_sqrtf(fmaxf(om[1], 0.0f))};
                        const f32x2 bv = sq * (ig * (f32x2){uu[n][h], uu[n][h + 1]});
                        la[4 * n + h] = l2[0]; la[4 * n + h + 1] = l2[1]; bb[4 * n + h] = bv[0]; bb[4 * n + h + 1] = bv[1]; }
                }
                u32x4 w; w.x = cvt_pk_bf16(la[0], la[1]); w.y = cvt_pk_bf16(la[2], la[3]); w.z = cvt_pk_bf16(la[4], la[5]); w.w = cvt_pk_bf16(la[6], la[7]);
                *(u32x4*)(LA + ((size_t)d * NT0 + row) * 1024 + ch0) = w;
                { f32x4 b0 = (f32x4){bb[0], bb[1], bb[2], bb[3]} * 16.0f, b1 = (f32x4){bb[4], bb[5], bb[6], bb[7]} * 16.0f;
#pragma unroll
                  for (int c = 0; c < 4; ++c) { b0[c] = fminf(fmaxf(b0[c], -448.0f), 448.0f); b1[c] = fminf(fmaxf(b1[c], -448.0f), 448.0f); }
                  u32x2 w8; w8.x = pack4_fp8(b0); w8.y = pack4_fp8(b1);
                  *(u32x2*)((unsigned char*)BBp + ((size_t)d * NT0 + row) * 1024 + ch0) = w8; }
            }
            asm volatile("" ::: "memory");
        }
    }
};

struct ProbOut {
    static constexpr bool GATHER = false; static constexpr int lda = 1024;
    unsigned A; int ldb; unsigned Bt; const float* g1; bf16_t* LAT;
    __device__ __forceinline__ int rot(int v) const { return 0; }
    __device__ __forceinline__ bool unit(int L, Unit& u) const { if (L >= 128 * 4) return false; u.pm = L >> 2; u.pn = L & 3; u.e = 0; u.aux = 0; return true; }
    __device__ __forceinline__ void aoff_next(const Unit& u, const int tid, unsigned (&v)[2][2], LAS unsigned char*) const { aoff_first(u, tid, v); }
    __device__ __forceinline__ void prefetch(const Unit&, const Unit&, bool, int, int, int, LAS unsigned char*) const {}
    __device__ __forceinline__ void aoff_first(const Unit& u, const int tid, unsigned (&v)[2][2]) const {
        int Ra[2], Ca[2]; pg8::stage_rc(tid * 16, Ra[0], Ca[0]); pg8::stage_rc(tid * 16 + 8192, Ra[1], Ca[1]);
#pragma unroll
        for (int h = 0; h < 2; ++h)
#pragma unroll
            for (int i = 0; i < 2; ++i) v[h][i] = A + (unsigned)((u.pm * 256 + h * 128 + Ra[i]) * 1024 + Ca[i]) * 2u;
    }
    __device__ __forceinline__ unsigned bbase(const Unit& u) const { return Bt + (unsigned)u.pn * (256u * 1024u * 2u); }
    __device__ __forceinline__ void epi(const AccT& acc, const Unit& u, int wr, int wc, int fr, int fq, LAS unsigned char* lds, int ui) const {
        const int b = u.pm >> 4; const int c0 = u.pn * 256 + wc * 32 + fq * 4;
        f32x4 gv[2][2];
#pragma unroll
        for (int bj = 0; bj < 2; ++bj)
#pragma unroll
            for (int n = 0; n < 2; ++n) gv[bj][n] = *(const f32x4*)(g1 + (size_t)b * 6144 + c0 + bj * 128 + n * 16);
#pragma unroll
        for (int ai = 0; ai < 2; ++ai)
#pragma unroll
            for (int mp = 0; mp < 2; ++mp) {
                u32x2 old[2][2][2];
#pragma unroll
                for (int mm = 0; mm < 2; ++mm) { const int row = u.pm * 256 + ai * 128 + wr * 64 + (2 * mp + mm) * 16 + fr; const bf16_t* rp = LAT + (size_t)row * 1024 + c0;
#pragma unroll
                    for (int bj = 0; bj < 2; ++bj)
#pragma unroll
                        for (int n = 0; n < 2; ++n) old[mm][bj][n] = *(const u32x2*)(rp + bj * 128 + n * 16); }
#pragma unroll
                for (int mm = 0; mm < 2; ++mm) { const int row = u.pm * 256 + ai * 128 + wr * 64 + (2 * mp + mm) * 16 + fr; bf16_t* rp = LAT + (size_t)row * 1024 + c0;
#pragma unroll
                    for (int bj = 0; bj < 2; ++bj)
#pragma unroll
                        for (int n = 0; n < 2; ++n) *(u32x2*)(rp + bj * 128 + n * 16) = pack4(unpack4(old[mm][bj][n]) + gv[bj][n] * acc[ai][bj][2 * mp + mm][n]); }
                asm volatile("" ::: "memory");
            }
    }
};

__device__ __forceinline__ void tr_item(const float* src, int ldw, int k0, int n0, bf16_t* dst, int ldd, int mapkind, int mp_d, int mp_ri, LAS float* scr, int lane) {
#pragma unroll 4
    for (int i = 0; i < 16; ++i) { const int kk = 4 * i + (lane >> 4); const f32x4 v = *(const f32x4*)(src + (size_t)(k0 + kk) * ldw + n0 + 4 * (lane & 15));
        LAS float* s = scr + kk * 65 + 4 * (lane & 15); s[0] = v[0]; s[1] = v[1]; s[2] = v[2]; s[3] = v[3]; }
    asm volatile("s_waitcnt lgkmcnt(0)" ::: "memory");
    const int c = lane & 7;
#pragma unroll
    for (int j = 0; j < 8; ++j) { const int nl = (lane >> 3) + 8 * j; const int n = n0 + nl; const LAS float* s = scr + (8 * c) * 65 + nl;
        u32x4 o; o.x = cvt_pk_bf16(s[0], s[65]); o.y = cvt_pk_bf16(s[2 * 65], s[3 * 65]); o.z = cvt_pk_bf16(s[4 * 65], s[5 * 65]); o.w = cvt_pk_bf16(s[6 * 65], s[7 * 65]);
        int row;
        if (mapkind == 0) row = n;
        else if (mapkind == 1) { const int jj = n & 1023; row = (jj >> 7) * 256 + (n >> 10) * 128 + (jj & 127); }
        else row = ((mp_d * 2 + (n >> 7)) * 2 + mp_ri) * 128 + (n & 127);
        *(u32x4*)(dst + (size_t)row * ldd + k0 + 8 * c) = o; }
    asm volatile("s_waitcnt lgkmcnt(0)" ::: "memory");
}

template <bool NT>
__device__ __forceinline__ void tr_item8r(const float* src, int ldw, int k0, int n0, unsigned char* dst, int ldd, int mapkind, int lane) {
    const int l16 = lane & 15, kb = lane >> 4;
    const float* sp = src + (size_t)(k0 + 16 * kb) * ldw + n0 + 4 * l16;
    f32x4 v[16];
#pragma unroll
    for (int i = 0; i < 16; ++i) v[i] = NT ? __builtin_nontemporal_load((const f32x4*)(sp + (size_t)i * ldw)) : *(const f32x4*)(sp + (size_t)i * ldw);
#pragma unroll
    for (int c = 0; c < 4; ++c) { const int n = n0 + 4 * l16 + c;
        u32x4 o;
        o.x = pack4_fp8((f32x4){v[0][c], v[1][c], v[2][c], v[3][c]} * 64.0f); o.y = pack4_fp8((f32x4){v[4][c], v[5][c], v[6][c], v[7][c]} * 64.0f);
        o.z = pack4_fp8((f32x4){v[8][c], v[9][c], v[10][c], v[11][c]} * 64.0f); o.w = pack4_fp8((f32x4){v[12][c], v[13][c], v[14][c], v[15][c]} * 64.0f);
        const int jj = n & 1023; const int row = mapkind ? ((jj >> 7) * 256 + (n >> 10) * 128 + (jj & 127)) : n;
        *(u32x4*)(dst + (size_t)row * ldd + k0 + 16 * kb) = o; }
}

template <bool NT>
__device__ __forceinline__ void tr_item8f(const float* src, int ldw, int k0, int n0, unsigned char* dst, int ldd, int mapkind, int lane) {
    const int l8 = lane & 7, kb = lane >> 3;
    const float* sp = src + (size_t)(k0 + 16 * kb) * ldw + n0 + 4 * l8;
    f32x4 v[16];
#pragma unroll
    for (int i = 0; i < 16; ++i) v[i] = NT ? __builtin_nontemporal_load((const f32x4*)(sp + (size_t)i * ldw)) : *(const f32x4*)(sp + (size_t)i * ldw);
#pragma unroll
    for (int c = 0; c < 4; ++c) { const int n = n0 + 4 * l8 + c;
        u32x4 o;
        o.x = pack4_fp8((f32x4){v[0][c], v[1][c], v[2][c], v[3][c]} * 64.0f); o.y = pack4_fp8((f32x4){v[4][c], v[5][c], v[6][c], v[7][c]} * 64.0f);
        o.z = pack4_fp8((f32x4){v[8][c], v[9][c], v[10][c], v[11][c]} * 64.0f); o.w = pack4_fp8((f32x4){v[12][c], v[13][c], v[14][c], v[15][c]} * 64.0f);
        const int jj = n & 1023; const int row = mapkind ? ((jj >> 7) * 256 + (n >> 10) * 128 + (jj & 127)) : n;
        *(u32x4*)(dst + (size_t)row * ldd + k0 + 16 * kb) = o; }
}

__device__ __forceinline__ void tr_item8(const float* src, int ldw, int k0, int n0, unsigned char* dst, int ldd, int mapkind, LAS float* scr, int lane) {
#pragma unroll 4
    for (int i = 0; i < 16; ++i) { const int kk = 4 * i + (lane >> 4); const f32x4 v = *(const f32x4*)(src + (size_t)(k0 + kk) * ldw + n0 + 4 * (lane & 15));
        LAS float* s = scr + kk * 65 + 4 * (lane & 15); s[0] = v[0]; s[1] = v[1]; s[2] = v[2]; s[3] = v[3]; }
    asm volatile("s_waitcnt lgkmcnt(0)" ::: "memory");
    const int c = lane & 3;
#pragma unroll
    for (int j = 0; j < 4; ++j) { const int nl = (lane >> 2) + 16 * j; const int n = n0 + nl; const LAS float* s = scr + (16 * c) * 65 + nl;
        u32x4 o;
        o.x = pack4_fp8((f32x4){s[0], s[65], s[2 * 65], s[3 * 65]} * 64.0f); o.y = pack4_fp8((f32x4){s[4 * 65], s[5 * 65], s[6 * 65], s[7 * 65]} * 64.0f);
        o.z = pack4_fp8((f32x4){s[8 * 65], s[9 * 65], s[10 * 65], s[11 * 65]} * 64.0f); o.w = pack4_fp8((f32x4){s[12 * 65], s[13 * 65], s[14 * 65], s[15 * 65]} * 64.0f);
        const int jj = n & 1023; const int row = mapkind ? ((jj >> 7) * 256 + (n >> 10) * 128 + (jj & 127)) : n;
        *(u32x4*)(dst + (size_t)row * ldd + k0 + 16 * c) = o; }
    asm volatile("s_waitcnt lgkmcnt(0)" ::: "memory");
}

__device__ __forceinline__ void phase_prep(const Params& p, LAS unsigned char* lds, int bid, int G, const int wvi) {
    unsigned char* const ws = launder_ptr(p.ws);
    const int tid = my_tid(wvi), lane = tid & 63, wave = tid >> 6;
    const float* cvec = kin(1); const float* cctx = kin(3); const float* adaw = kin(4); const float* adab = kin(5);
    for (int item = bid; item < 192; item += G) {
        LAS float* sc = (LAS float*)lds; LAS float* red = (LAS float*)(lds + 36864);
        for (int i = tid; i < 9 * 1024; i += NTHR) { const float v = i < 8192 ? cvec[i] : cctx[i - 8192]; sc[i] = v * fast_rcp(1.0f + __expf(-v)); }
        __syncthreads();
        const int l = item / 96, n0 = (item % 96) * 64, kq = tid >> 4, cq = tid & 15;
        f32x4 acc[9];
#pragma unroll
        for (int b = 0; b < 9; ++b) acc[b] = (f32x4){0.f, 0.f, 0.f, 0.f};
        const float* W = adaw + (size_t)l * 1024 * 6144 + n0 + 4 * cq;
#pragma unroll 4
        for (int kk = 0; kk < 32; ++kk) { const int k = kq + 32 * kk; const f32x4 w = *(const f32x4*)(W + (size_t)k * 6144);
#pragma unroll
            for (int b = 0; b < 9; ++b) acc[b] += sc[b * 1024 + k] * w; }
#pragma unroll
        for (int b = 0; b < 9; ++b)
#pragma unroll
            for (int c = 0; c < 4; ++c) { float v = acc[b][c]; v += sx<16>(v); v += sx<32>(v); acc[b][c] = v; }
        if (lane < 16) {
#pragma unroll
            for (int b = 0; b < 9; ++b) *(LAS f32x4*)(red + (wave * 9 + b) * 64 + 4 * cq) = acc[b]; }
        __syncthreads();
        for (int o = tid; o < 576; o += NTHR) { const int b = o >> 6, c = o & 63; float s = 0.f;
#pragma unroll
            for (int w = 0; w < 8; ++w) s += red[(w * 9 + b) * 64 + c];
            ((float*)(ws + WS_MOD))[(size_t)(l * 9 + b) * 6144 + n0 + c] = s + adab[l * 6144 + n0 + c]; }
        __syncthreads();
    }
    if (bid == G - 1) { const float* lamp = kin(17); for (int i = tid; i < 2048; i += NTHR) ((float*)(ws + WS_CTL + CTL_SP8))[i] = 8.0f * log1p_l2(__expf(-lamp[i])); }
    LAS float* scr = (LAS float*)(lds + wave * 16640);
    constexpr int NITEMS = 16384 + 8192 + 64 + 512 + 256 + 256;
    unsigned* q0 = (unsigned*)(ws + WS_CTL + CTL_Q0);
    volatile LAS unsigned* shq = (volatile LAS unsigned*)(lds + 8 * 16640);
    __syncthreads();
    if (tid == 0) shq[0] = __hip_atomic_fetch_add(q0, 8u, __ATOMIC_RELAXED, __HIP_MEMORY_SCOPE_AGENT);
    __syncthreads();
    unsigned basei = shq[0];
    __syncthreads();
    while (basei < (unsigned)NITEMS) {
        unsigned nvq = 0u; if (tid == 0) nvq = __hip_atomic_fetch_add(q0, 8u, __ATOMIC_RELAXED, __HIP_MEMORY_SCOPE_AGENT);
        const int it = (int)basei + wave;
        if (it < NITEMS) do {
        int r = it;
        if (r < 16384) { const int le = r >> 9, q = r & 511; tr_item8f<false>(kin(21) + (size_t)le * 1024 * 2048, 2048, (q >> 6) * 128, (q & 63) * 32, ws + WS_WGU + (size_t)le * 2048 * 1024, 1024, 1, lane); break; }
        r -= 16384;
        if (r < 8192) { const int le = r >> 8, q = r & 255; tr_item8f<false>(kin(23) + (size_t)le * 1024 * 1024, 1024, (q >> 5) * 128, (q & 31) * 32, ws + WS_WDN + (size_t)le * 1024 * 1024, 1024, 0, lane); break; }
        r -= 8192;
        if (r < 64) { const int g = r >> 4, q = r & 15; tr_item(kin(8) + (size_t)g * 65536, 256, (q >> 2) * 64, (q & 3) * 64, (bf16_t*)(ws + WS_WPOOL) + (size_t)g * 65536, 256, 0, 0, 0, scr, lane); break; }
        r -= 64;
        if (r < 512) { tr_item(kin(10), 2048, (r >> 5) * 64, (r & 31) * 64, (bf16_t*)(ws + WS_WIN), 1024, 0, 0, 0, scr, lane); break; }
        r -= 512;
        if (r < 256) { const int m16 = r >> 4, q = r & 15, ri = m16 >> 3, d = (m16 >> 2) & 1, head = m16 & 3;
            tr_item((ri ? kin(15) : kin(13)) + (size_t)(d * 4 + head) * 65536, 256, (q >> 2) * 64, (q & 3) * 64, (bf16_t*)(ws + WS_WGATE) + (size_t)head * 1024 * 256, 256, 2, d, ri, scr, lane); break; }
        r -= 256;
        tr_item(kin(18), 1024, (r >> 4) * 64, (r & 15) * 64, (bf16_t*)(ws + WS_WOUT), 1024, 0, 0, 0, scr, lane);
        } while (0);
        if (tid == 0) shq[0] = nvq;
        __syncthreads();
        basei = shq[0];
        __syncthreads();
    }
}

__device__ __forceinline__ void tr_item8q(const float* src, int ldw, int k0, int n0, unsigned char* dst, int ldd, int mapkind, LAS float* scr, int lane) {
    f32x4 vv[16];
#pragma unroll
    for (int i = 0; i < 16; ++i) { const int kk = 4 * i + (lane >> 4); vv[i] = __builtin_nontemporal_load((const f32x4*)(src + (size_t)(k0 + kk) * ldw + n0 + 4 * (lane & 15))); }
#pragma unroll
    for (int i = 0; i < 16; ++i) { const int kk = 4 * i + (lane >> 4); const f32x4 v = vv[i];
        LAS float* s = scr + kk * 65 + 4 * (lane & 15); s[0] = v[0]; s[1] = v[1]; s[2] = v[2]; s[3] = v[3]; }
    asm volatile("s_waitcnt lgkmcnt(0)" ::: "memory");
    const int c = lane & 3;
#pragma unroll
    for (int j = 0; j < 4; ++j) { const int nl = (lane >> 2) + 16 * j; const int n = n0 + nl; const LAS float* s = scr + (16 * c) * 65 + nl;
        u32x4 o;
        o.x = pack4_fp8((f32x4){s[0], s[65], s[2 * 65], s[3 * 65]} * 64.0f); o.y = pack4_fp8((f32x4){s[4 * 65], s[5 * 65], s[6 * 65], s[7 * 65]} * 64.0f);
        o.z = pack4_fp8((f32x4){s[8 * 65], s[9 * 65], s[10 * 65], s[11 * 65]} * 64.0f); o.w = pack4_fp8((f32x4){s[12 * 65], s[13 * 65], s[14 * 65], s[15 * 65]} * 64.0f);
        const int jj = n & 1023; const int row = mapkind ? ((jj >> 7) * 256 + (n >> 10) * 128 + (jj & 127)) : n;
        *(u32x4*)(dst + (size_t)row * ldd + k0 + 16 * c) = o; }
    asm volatile("s_waitcnt lgkmcnt(0)" ::: "memory");
}
__device__ __forceinline__ void wq_item(unsigned idx, unsigned char* ws, LAS float* scr, int lane) {
    if (idx < 16384u) { const int le = 32 + (int)(idx >> 9), q = (int)(idx & 511u); tr_item8f<true>(kin(21) + (size_t)le * 1024 * 2048, 2048, (q >> 6) * 128, (q & 63) * 32, ws + WS_WGU + (size_t)le * 2048 * 1024, 1024, 1, lane); }
    else { const unsigned r = idx - 16384u; const int le = 32 + (int)(r >> 8), q = (int)(r & 255u); tr_item8f<true>(kin(23) + (size_t)le * 1024 * 1024, 1024, (q >> 5) * 128, (q & 31) * 32, ws + WS_WDN + (size_t)le * 1024 * 1024, 1024, 0, lane); }
}
__device__ __forceinline__ void weight_queue(const Params& p, LAS unsigned char* lds, const int wvi, const int slot, const unsigned need, const int bid, const int G) {
    unsigned char* const ws = launder_ptr(p.ws);
    const int tid = my_tid(wvi), lane = tid & 63, wave = tid >> 6;
    LAS float* scr = (LAS float*)(lds + wave * 16640);
    volatile LAS unsigned* sh = (volatile LAS unsigned*)(lds + 8 * 16640);
    unsigned* qc = (unsigned*)(ws + WS_CTL + CTL_Q);
    if (slot < 0) {
        unsigned start = __hip_atomic_load(qc, __ATOMIC_RELAXED, __HIP_MEMORY_SCOPE_AGENT); start = (unsigned)__builtin_amdgcn_readfirstlane((int)start);
        if (start > NQ_ITEMS) start = NQ_ITEMS;
        for (unsigned it = start + (unsigned)(bid * 8 + wave); it < NQ_ITEMS; it += (unsigned)(G * 8)) wq_item(it, ws, scr, lane);
        unsigned nret = __hip_atomic_load((unsigned*)(ws + WS_CTL + CTL_NRET), __ATOMIC_RELAXED, __HIP_MEMORY_SCOPE_AGENT); nret = (unsigned)__builtin_amdgcn_readfirstlane((int)nret);
        for (unsigned r = (unsigned)bid; r < nret; r += (unsigned)G) {
            unsigned b0 = __hip_atomic_load((unsigned*)(ws + WS_CTL + CTL_RET) + r, __ATOMIC_RELAXED, __HIP_MEMORY_SCOPE_AGENT); b0 = (unsigned)__builtin_amdgcn_readfirstlane((int)b0);
            if (b0 + (unsigned)wave < NQ_ITEMS) wq_item(b0 + (unsigned)wave, ws, scr, lane); }
        return;
    }
    unsigned* done = (unsigned*)(ws + WS_CTL + CTL_DONE + 64 * slot);
    if (tid == 0) sh[0] = __hip_atomic_fetch_add(qc, 8u, __ATOMIC_RELAXED, __HIP_MEMORY_SCOPE_AGENT);
    __syncthreads();
    unsigned base = sh[0];
    __syncthreads();
    while (base < NQ_ITEMS) {
        unsigned nv = 0u, dv = 0u;
        if (tid == 0) nv = __hip_atomic_fetch_add(qc, 8u, __ATOMIC_RELAXED, __HIP_MEMORY_SCOPE_AGENT);
        if (base + (unsigned)wave < NQ_ITEMS) wq_item(base + (unsigned)wave, ws, scr, lane);
        if (tid == 0) { dv = __hip_atomic_load(done, __ATOMIC_RELAXED, __HIP_MEMORY_SCOPE_AGENT); sh[0] = nv; sh[1] = dv; }
        __syncthreads();
        const unsigned nxt = sh[0], dcur = sh[1];
        __syncthreads();
        if (dcur >= need) {
            if (tid == 0 && nxt < NQ_ITEMS) { const unsigned rs = __hip_atomic_fetch_add((unsigned*)(ws + WS_CTL + CTL_NRET), 1u, __ATOMIC_RELAXED, __HIP_MEMORY_SCOPE_AGENT);
                __hip_atomic_store((unsigned*)(ws + WS_CTL + CTL_RET) + rs, nxt, __ATOMIC_RELAXED, __HIP_MEMORY_SCOPE_AGENT); }
            break; }
        base = nxt;
    }
}
__device__ __forceinline__ int gemm_split(int units, int vid, int G, int& Gg, int& nstop) {
    const int R = (units + G - 1) / G; Gg = R > 0 ? (units + R - 1) / R : G;
    nstop = R * Gg - units + 2;
    if ((G & 7) || Gg >= G) { Gg = G; return vid; }
    const int Gx = G >> 3, S = G - Gg, x = vid / Gx, c = vid - x * Gx, sb = S >> 3, sr = S & 7;
    const int ng = Gx - sb - (x < sr ? 1 : 0);
    return c < ng ? x * Gx - (x * sb + (x < sr ? x : sr)) + c : -1;
}

__device__ __forceinline__ void phase_norm0(const Params& p, int bid, int G, const int wvi) {
    unsigned char* const ws = launder_ptr(p.ws);
    const int tid = my_tid(wvi), lane = tid & 63, wave = tid >> 6;
    const float* mod = (const float*)(ws + WS_MOD);
    bf16_t* H = (bf16_t*)(ws + WS_H);
    const float* xin = kin(0); const float* cin = kin(2); const float* gain0 = kin(6);
    for (int tok = bid * 8 + wave; tok < NT0; tok += G * 8) {
        const float* src = tok < NL ? xin + (size_t)tok * 1024 : cin + (size_t)(tok - NL) * 1024;
        const int bi = tok < NL ? (tok >> 12) : 8;
        f32x4 v[4]; float ss = 0.f;
#pragma unroll
        for (int j = 0; j < 4; ++j) { v[j] = *(const f32x4*)(src + 256 * j + 4 * lane); ss += v[j][0] * v[j][0] + v[j][1] * v[j][1] + v[j][2] * v[j][2] + v[j][3] * v[j][3]; }
        const float rstd = rsqrtf(wave_sum(ss) * (1.0f / 1024.0f) + 1e-6f);
        const float* mb = mod + (size_t)bi * 6144;
#pragma unroll
        for (int j = 0; j < 4; ++j) { const int ch = 256 * j + 4 * lane;
            const f32x4 gn = *(const f32x4*)(gain0 + ch), sh = *(const f32x4*)(mb + ch), sc = *(const f32x4*)(mb + 1024 + ch);
            const f32x4 h = v[j] * rstd * gn * (1.0f + sc) + sh;
            *(u32x2*)(H + (size_t)tok * 1024 + ch) = pack4(h); }
    }
}

__device__ __forceinline__ void phase_pool(const Params& p, LAS unsigned char* lds, int bid, int G, const int wvi) {
    unsigned char* const ws = launder_ptr(p.ws);
    const int tid = my_tid(wvi), tk = tid >> 3, sub = tid & 7;
    const bf16_t* Z = (const bf16_t*)(ws + WS_Z);
    bf16_t* LAT = (bf16_t*)(ws + WS_LAT);
    const float* mod = (const float*)(ws + WS_MOD);
    LAS float* Vs = (LAS float*)lds;
    const float* xin = kin(0); const float* cin = kin(2); const float* pscale = kin(9);
    for (int item = bid; item < 2048 + 128; item += G) {
        if (item < 2048) {
            const int b = item >> 8, r0 = ((item >> 4) & 15) * 4, cq = (item >> 2) & 3, g = (item + item / G) & 3, hw = 1 << g;
            const int chb = g * 256 + cq * 64 + sub * 8;
            f32x4 V[4][2], xv[4][2]; u32x4 zc[4];
#pragma unroll
            for (int q = 0; q < 4; ++q) { const size_t rowx = (size_t)b * 4096 + (r0 + q) * 64 + tk;
                xv[q][0] = *(const f32x4*)(xin + rowx * 1024 + chb); xv[q][1] = *(const f32x4*)(xin + rowx * 1024 + chb + 4);
                V[q][0] = (f32x4){0.f, 0.f, 0.f, 0.f}; V[q][1] = (f32x4){0.f, 0.f, 0.f, 0.f}; zc[q] = (u32x4){0u, 0u, 0u, 0u}; }
            const int wlo = max(r0 - hw, 0), whi = min(r0 + 3 + hw, 64);
            for (int rr = wlo; rr < whi; rr += 8) {
                u32x4 w8[8];
#pragma unroll
                for (int i = 0; i < 8; ++i) w8[i] = (rr + i < whi) ? *(const u32x4*)(Z + ((size_t)(b * 4096 + (rr + i) * 64 + tk)) * 1024 + chb) : (u32x4){0u, 0u, 0u, 0u};
#pragma unroll
                for (int i = 0; i < 8; ++i) { const u32x4 w = w8[i]; const int row = rr + i;
                    const f32x4 lo = (f32x4){bf_lo(w.x), bf_hi(w.x), bf_lo(w.y), bf_hi(w.y)}, hi = (f32x4){bf_lo(w.z), bf_hi(w.z), bf_lo(w.w), bf_hi(w.w)};
#pragma unroll
                    for (int q = 0; q < 4; ++q) { const float m = (row >= r0 + q - hw && row < r0 + q + hw && row < whi) ? 1.0f : 0.0f;
                        V[q][0] += m * lo; V[q][1] += m * hi;
                        if (row == r0 + q) zc[q] = w; } }
            }
#pragma unroll
            for (int q = 0; q < 4; ++q) { *(LAS f32x4*)(Vs + (q * 64 + tk) * 68 + sub * 8) = V[q][0]; *(LAS f32x4*)(Vs + (q * 64 + tk) * 68 + sub * 8 + 4) = V[q][1]; }
            __syncthreads();
            const int c0 = max(tk - hw, 0), c1 = min(tk + hw, 64);
            f32x4 Hs[4][2];
#pragma unroll
            for (int q = 0; q < 4; ++q) { Hs[q][0] = (f32x4){0.f, 0.f, 0.f, 0.f}; Hs[q][1] = (f32x4){0.f, 0.f, 0.f, 0.f}; }
            for (int cc = c0; cc < c1; ++cc) {
#pragma unroll
                for (int q = 0; q < 4; ++q) { Hs[q][0] += *(const LAS f32x4*)(Vs + (q * 64 + cc) * 68 + sub * 8); Hs[q][1] += *(const LAS f32x4*)(Vs + (q * 64 + cc) * 68 + sub * 8 + 4); }
            }
            const float* g1 = mod + (size_t)b * 6144 + 2048;
            const f32x4 pv0 = *(const f32x4*)(pscale + chb), pv1 = *(const f32x4*)(pscale + chb + 4), gv0 = *(const f32x4*)(g1 + chb), gv1 = *(const f32x4*)(g1 + chb + 4);
#pragma unroll
            for (int q = 0; q < 4; ++q) {
                const int rq0 = max(r0 + q - hw, 0), rq1 = min(r0 + q + hw, 64);
                const float inv = 1.0f / (float)((rq1 - rq0) * (c1 - c0));
                const size_t row = (size_t)b * 4096 + (r0 + q) * 64 + tk;
                const f32x4 z0 = (f32x4){bf_lo(zc[q].x), bf_hi(zc[q].x), bf_lo(zc[q].y), bf_hi(zc[q].y)}, z1 = (f32x4){bf_lo(zc[q].z), bf_hi(zc[q].z), bf_lo(zc[q].w), bf_hi(zc[q].w)};
                const f32x4 y0 = (Hs[q][0] * inv - z0) * pv0, y1 = (Hs[q][1] * inv - z1) * pv1;
                { const u32x2 lo = pack4(xv[q][0] + gv0 * y0), hi = pack4(xv[q][1] + gv1 * y1); *(u32x4*)(LAT + row * 1024 + chb) = (u32x4){lo.x, lo.y, hi.x, hi.y}; } }
            __syncthreads();
        } else {
            const int q = item - 2048, b = q >> 4, sc4 = (q >> 2) & 3, g = q & 3, hw = 1 << g;
            const int s = sc4 * 64 + tk, c0 = max(s - hw, 0), c1 = min(s + hw, 256);
            const int chb = g * 256 + sub * 8;
            f32x4 Hs[4][2];
#pragma unroll
            for (int j = 0; j < 4; ++j) { Hs[j][0] = (f32x4){0.f, 0.f, 0.f, 0.f}; Hs[j][1] = (f32x4){0.f, 0.f, 0.f, 0.f}; }
            for (int cb = c0; cb < c1; cb += 8) {
                u32x4 w8[8][4];
#pragma unroll
                for (int q8 = 0; q8 < 8; ++q8) { const int cc = min(cb + q8, c1 - 1); const bf16_t* zp = Z + ((size_t)(NL + b * 256 + cc)) * 1024 + chb;
#pragma unroll
                    for (int j = 0; j < 4; ++j) w8[q8][j] = *(const u32x4*)(zp + 64 * j); }
#pragma unroll
                for (int q8 = 0; q8 < 8; ++q8) { const float wq = (cb + q8 < c1) ? 1.0f : 0.0f;
#pragma unroll
                    for (int j = 0; j < 4; ++j) { const u32x4 w = w8[q8][j];
                        Hs[j][0] += wq * (f32x4){bf_lo(w.x), bf_hi(w.x), bf_lo(w.y), bf_hi(w.y)}; Hs[j][1] += wq * (f32x4){bf_lo(w.z), bf_hi(w.z), bf_lo(w.w), bf_hi(w.w)}; } }
            }
            const float inv = 1.0f / (float)(c1 - c0);
            const size_t crow = (size_t)b * 256 + s, row = NL + crow;
            const float* g1 = mod + (size_t)8 * 6144 + 2048;
            f32x4 xv[4][2], pv4[4][2], gv4[4][2]; u32x4 zw[4];
#pragma unroll
            for (int j = 0; j < 4; ++j) { const int ch = chb + 64 * j; zw[j] = *(const u32x4*)(Z + row * 1024 + ch);
                xv[j][0] = *(const f32x4*)(cin + crow * 1024 + ch); xv[j][1] = *(const f32x4*)(cin + crow * 1024 + ch + 4);
                pv4[j][0] = *(const f32x4*)(pscale + ch); pv4[j][1] = *(const f32x4*)(pscale + ch + 4);
                gv4[j][0] = *(const f32x4*)(g1 + ch); gv4[j][1] = *(const f32x4*)(g1 + ch + 4); }
#pragma unroll
            for (int j = 0; j < 4; ++j) { const int ch = chb + 64 * j; const u32x4 w = zw[j];
                const f32x4 z0 = (f32x4){bf_lo(w.x), bf_hi(w.x), bf_lo(w.y), bf_hi(w.y)}, z1 = (f32x4){bf_lo(w.z), bf_hi(w.z), bf_lo(w.w), bf_hi(w.w)};
                const f32x4 y0 = (Hs[j][0] * inv - z0) * pv4[j][0], y1 = (Hs[j][1] * inv - z1) * pv4[j][1];
                { const u32x2 lo = pack4(xv[j][0] + gv4[j][0] * y0), hi = pack4(xv[j][1] + gv4[j][1] * y1); *(u32x4*)(LAT + row * 1024 + ch) = (u32x4){lo.x, lo.y, hi.x, hi.y}; } }
        }
    }
}

template <bool FINAL>
__device__ __forceinline__ void combine_phase(const Params& p, LAS unsigned char* lds, int bid, int G, int ntok, const float* gain, int mod_l, int sh_off, int comb_l, const int wvi) {
    unsigned char* const ws = launder_ptr(p.ws);
    const int tid = my_tid(wvi), lane = tid & 63, wave = tid >> 6;
    const float* mod = (const float*)(ws + WS_MOD);
    bf16_t* LAT = (bf16_t*)(ws + WS_LAT);
    bf16_t* H = (bf16_t*)(ws + WS_H);
    const int* TKE = (const int*)(ws + WS_TKE); const float* TKW = (const float*)(ws + WS_TKW); const int* POS = (const int*)(ws + WS_POS);
    const bf16_t* OUTB = (const bf16_t*)(ws + WS_OUTB);
    LAS int* tab = (LAS int*)(lds + 98304 + 256);
    moe_table(tab, (const int*)(ws + WS_CTL + CTL_CNT + 256 * comb_l), wvi);
    float* const outp = FINAL ? (float*)launder_ptr(p.out) : nullptr;
    const int npair = ntok >> 1, pstride = G * 8;
    int pi = bid * 8 + wave;
    i32x4 ev[2], pv[2]; f32x4 wv[2];
    if (pi < npair) {
#pragma unroll
        for (int s = 0; s < 2; ++s) { const size_t t4 = (size_t)(2 * pi + s) * 4; ev[s] = *(const i32x4*)(TKE + t4); pv[s] = *(const i32x4*)(POS + t4); wv[s] = *(const f32x4*)(TKW + t4); }
    }
    for (; pi < npair; pi += pstride) {
        const int tok0 = 2 * pi;
        const int bi = tok0 < NL ? (tok0 >> 12) : 8;
        f32x4 v[2][4]; unsigned orw[2][4][4]; f32x4 wcur[2];
#pragma unroll
        for (int s = 0; s < 2; ++s) {
            wcur[s] = wv[s];
#pragma unroll
            for (int j = 0; j < 4; ++j) v[s][j] = unpack4(*(const u32x2*)(LAT + (size_t)(tok0 + s) * 1024 + 256 * j + 4 * lane));
#pragma unroll
            for (int k = 0; k < 4; ++k) { const int slot = tab[ev[s][k]] * 256 + pv[s][k]; const unsigned char* op = (const unsigned char*)OUTB + (size_t)slot * 1024 + 4 * lane;
#pragma unroll
                for (int j = 0; j < 4; ++j) orw[s][k][j] = *(const unsigned*)(op + 256 * j); }
        }
        f32x4 g2v[4], gnv[4], scv[4], shv[4];
        { const float* g2 = mod + ((size_t)comb_l * 9 + bi) * 6144 + 5120; const float* mb = mod + ((size_t)mod_l * 9 + bi) * 6144 + sh_off;
#pragma unroll
          for (int j = 0; j < 4; ++j) { const int ch = 256 * j + 4 * lane; g2v[j] = *(const f32x4*)(g2 + ch); gnv[j] = *(const f32x4*)(gain + ch);
              if (!FINAL) { shv[j] = *(const f32x4*)(mb + ch); scv[j] = *(const f32x4*)(mb + 1024 + ch); } } }
        { const int pn = pi + pstride;
          if (pn < npair) {
#pragma unroll
              for (int s = 0; s < 2; ++s) { const size_t t4 = (size_t)(2 * pn + s) * 4; ev[s] = *(const i32x4*)(TKE + t4); pv[s] = *(const i32x4*)(POS + t4); wv[s] = *(const f32x4*)(TKW + t4); } } }
        float ss[2];
#pragma unroll
        for (int s = 0; s < 2; ++s) {
            ss[s] = 0.f;
#pragma unroll
            for (int j = 0; j < 4; ++j) { f32x4 y = (f32x4){0.f, 0.f, 0.f, 0.f};
#pragma unroll
                for (int k = 0; k < 4; ++k) y += wcur[s][k] * unpack4_fp8(orw[s][k][j]);
                v[s][j] += g2v[j] * (y * 0.0625f);
                if (!FINAL) *(u32x2*)(LAT + (size_t)(tok0 + s) * 1024 + 256 * j + 4 * lane) = pack4(v[s][j]);
                ss[s] += v[s][j][0] * v[s][j][0] + v[s][j][1] * v[s][j][1] + v[s][j][2] * v[s][j][2] + v[s][j][3] * v[s][j][3]; }
        }
#define SX2(O, a, b) { a += sx<O>(a); b += sx<O>(b); }
        SX2(1, ss[0], ss[1]) SX2(2, ss[0], ss[1]) SX2(4, ss[0], ss[1]) SX2(8, ss[0], ss[1]) SX2(16, ss[0], ss[1]) SX2(32, ss[0], ss[1])
#pragma unroll
        for (int s = 0; s < 2; ++s) {
            const float rstd = rsqrtf(ss[s] * (1.0f / 1024.0f) + 1e-6f);
#pragma unroll
            for (int j = 0; j < 4; ++j) { const int ch = 256 * j + 4 * lane;
                if (FINAL) *(f32x4*)(outp + (size_t)(tok0 + s) * 1024 + ch) = v[s][j] * rstd * gnv[j];
                else *(u32x2*)(H + (size_t)(tok0 + s) * 1024 + ch) = pack4(v[s][j] * rstd * gnv[j] * (1.0f + scv[j]) + shv[j]); }
        }
    }
}

__device__ __forceinline__ void router_phase(const Params& p, LAS unsigned char* lds, int bid, int G, int ntok, const float* gain, int mod_l, int sh_off, int rt_l, const int wvi) {
    unsigned char* const ws = launder_ptr(p.ws);
    const int tid = my_tid(wvi), lane = tid & 63, wave = tid >> 6;
    const float* mod = (const float*)(ws + WS_MOD);
    const bf16_t* LAT = (const bf16_t*)(ws + WS_LAT);
    unsigned char* H8 = ws + WS_H8;
    int* TKE = (int*)(ws + WS_TKE); float* TKW = (float*)(ws + WS_TKW); int* POS = (int*)(ws + WS_POS);
    LAS unsigned char* hsH = lds;
    LAS unsigned char* hsL = lds + 33280;
    LAS float* part = (LAS float*)(lds + 67584);
    LAS int* hist = (LAS int*)(lds + 98304);
    LAS int* basev = (LAS int*)(lds + 98304 + 128);
    if (tid < 32) hist[tid] = 0;
    u32x4 WH[8], WL[8];
    const int re = lane & 31, e16 = lane & 15, lg = lane >> 4;
    const float rbias = kin(20)[rt_l * 32 + re];
    { const float* rw = kin(19) + (size_t)rt_l * 1024 * 32;
#pragma unroll
      for (int i = 0; i < 8; ++i) { const float* wp = rw + (size_t)(128 * wave + 32 * (i >> 1) + 8 * lg) * 32 + 16 * (i & 1) + e16;
          float wv8[8];
#pragma unroll
          for (int c = 0; c < 8; ++c) wv8[c] = wp[c * 32];
          u32x4 hi, lo; hi.x = cvt_pk_bf16(wv8[0], wv8[1]); hi.y = cvt_pk_bf16(wv8[2], wv8[3]); hi.z = cvt_pk_bf16(wv8[4], wv8[5]); hi.w = cvt_pk_bf16(wv8[6], wv8[7]);
          lo.x = cvt_pk_bf16(wv8[0] - bf_lo(hi.x), wv8[1] - bf_hi(hi.x)); lo.y = cvt_pk_bf16(wv8[2] - bf_lo(hi.y), wv8[3] - bf_hi(hi.y));
          lo.z = cvt_pk_bf16(wv8[4] - bf_lo(hi.z), wv8[5] - bf_hi(hi.z)); lo.w = cvt_pk_bf16(wv8[6] - bf_lo(hi.w), wv8[7] - bf_hi(hi.w));
          WH[i] = hi; WL[i] = lo; } }
    f32x4 gn[4];
#pragma unroll
    for (int j = 0; j < 4; ++j) gn[j] = *(const f32x4*)(gain + 256 * j + 4 * lane);
    const int nb = ntok >> 4;
    f32x4 lat[2][4], scv[4], shv[4];
#define RT_ISSUE(btx) do { const int _t0 = (btx) * 16 + wave * 2; const int _bi = _t0 < NL ? (_t0 >> 12) : 8; const float* _mb = mod + ((size_t)mod_l * 9 + _bi) * 6144 + sh_off; \
        _Pragma("unroll") for (int j = 0; j < 4; ++j) { lat[0][j] = unpack4(*(const u32x2*)(LAT + (size_t)_t0 * 1024 + 256 * j + 4 * lane)); lat[1][j] = unpack4(*(const u32x2*)(LAT + (size_t)(_t0 + 1) * 1024 + 256 * j + 4 * lane)); \
            shv[j] = *(const f32x4*)(_mb + 256 * j + 4 * lane); scv[j] = *(const f32x4*)(_mb + 1024 + 256 * j + 4 * lane); } } while (0)
    if (bid < nb) RT_ISSUE(bid);
    for (int bt = bid; bt < nb; bt += G) {
        float ss0 = 0.f, ss1 = 0.f;
#pragma unroll
        for (int j = 0; j < 4; ++j) { ss0 += lat[0][j][0] * lat[0][j][0] + lat[0][j][1] * lat[0][j][1] + lat[0][j][2] * lat[0][j][2] + lat[0][j][3] * lat[0][j][3];
                                      ss1 += lat[1][j][0] * lat[1][j][0] + lat[1][j][1] * lat[1][j][1] + lat[1][j][2] * lat[1][j][2] + lat[1][j][3] * lat[1][j][3]; }
        SX2(1, ss0, ss1) SX2(2, ss0, ss1) SX2(4, ss0, ss1) SX2(8, ss0, ss1) SX2(16, ss0, ss1) SX2(32, ss0, ss1)
        const float rs0 = rsqrtf(ss0 * (1.0f / 1024.0f) + 1e-6f), rs1 = rsqrtf(ss1 * (1.0f / 1024.0f) + 1e-6f);
        const int tok0 = bt * 16 + wave * 2;
#pragma unroll
        for (int j = 0; j < 4; ++j) { const int ch = 256 * j + 4 * lane; const f32x4 gm = gn[j] * (1.0f + scv[j]);
            const f32x4 h0 = lat[0][j] * rs0 * gm + shv[j], h1 = lat[1][j] * rs1 * gm + shv[j];
            *(unsigned*)(H8 + (size_t)tok0 * 1024 + ch) = pack4_fp8(h0); *(unsigned*)(H8 + (size_t)(tok0 + 1) * 1024 + ch) = pack4_fp8(h1);
            { const u32x2 a0 = pack4(h0), a1 = pack4(h1); const u32x2 b0 = pack4(h0 - unpack4(a0)), b1 = pack4(h1 - unpack4(a1));
              *(LAS u32x2*)(hsH + (wave * 2) * 2080 + ch * 2) = a0; *(LAS u32x2*)(hsH + (wave * 2 + 1) * 2080 + ch * 2) = a1;
              *(LAS u32x2*)(hsL + (wave * 2) * 2080 + ch * 2) = b0; *(LAS u32x2*)(hsL + (wave * 2 + 1) * 2080 + ch * 2) = b1; } }
        if (bt + G < nb) RT_ISSUE(bt + G);
        __syncthreads();
        {
            f32x4 lacc[2] = {(f32x4){0.f, 0.f, 0.f, 0.f}, (f32x4){0.f, 0.f, 0.f, 0.f}};
            u32x4 ah[4], al[4];
#pragma unroll
            for (int sI = 0; sI < 4; ++sI) { const int o = e16 * 2080 + (128 * wave + 32 * sI + 8 * lg) * 2; ah[sI] = *(const LAS u32x4*)(hsH + o); al[sI] = *(const LAS u32x4*)(hsL + o); }
#pragma unroll
            for (int sI = 0; sI < 4; ++sI)
#pragma unroll
                for (int eb = 0; eb < 2; ++eb) {
                    lacc[eb] = __builtin_amdgcn_mfma_f32_16x16x32_bf16((bf16x8)ah[sI], (bf16x8)WH[sI * 2 + eb], lacc[eb], 0, 0, 0);
                    lacc[eb] = __builtin_amdgcn_mfma_f32_16x16x32_bf16((bf16x8)ah[sI], (bf16x8)WL[sI * 2 + eb], lacc[eb], 0, 0, 0);
                    lacc[eb] = __builtin_amdgcn_mfma_f32_16x16x32_bf16((bf16x8)al[sI], (bf16x8)WH[sI * 2 + eb], lacc[eb], 0, 0, 0);
                }
#pragma unroll
            for (int eb = 0; eb < 2; ++eb)
#pragma unroll
                for (int i = 0; i < 4; ++i) part[((4 * lg + i) * 8 + wave) * 32 + eb * 16 + e16] = lacc[eb][i];
        }
        __syncthreads();
        {
            const int t16 = tid >> 5, e = tid & 31, tok = bt * 16 + t16;
            float v = rbias;
#pragma unroll
            for (int sct = 0; sct < 8; ++sct) v += part[(t16 * 8 + sct) * 32 + e];
            LAS float* lg = (LAS float*)(lds + 98304 + 1024) + t16 * 64;
            lg[e] = v;
            int rank = 0;
#pragma unroll
            for (int q4 = 0; q4 < 8; ++q4) { const f32x4 o = *(const LAS f32x4*)(lg + 4 * q4);
#pragma unroll
                for (int c = 0; c < 4; ++c) { const int j = 4 * q4 + c; rank += (o[c] > v || (o[c] == v && j < e)) ? 1 : 0; } }
            if (rank < 4) lg[32 + rank] = v;
            const f32x4 tv = *(const LAS f32x4*)(lg + 32);
            const float e0 = 1.0f, e1 = __expf(tv[1] - tv[0]), e2 = __expf(tv[2] - tv[0]), e3 = __expf(tv[3] - tv[0]);
            const float inv = 1.0f / (e0 + e1 + e2 + e3);
            if (rank < 4) { const float mye = __expf(v - tv[0]); TKE[(size_t)tok * 4 + rank] = e; TKW[(size_t)tok * 4 + rank] = mye * inv; POS[(size_t)tok * 4 + rank] = atomicAdd((int*)&hist[e], 1); }
        }
    }
#undef RT_ISSUE
    __syncthreads();
    if (tid < 32) basev[tid] = atomicAdd((int*)(ws + WS_CTL + CTL_CNT + 256 * rt_l) + tid, hist[tid]);
    __syncthreads();
    { int* LIST = (int*)(ws + WS_LIST);
      const int nmine = bid < nb ? (nb - bid + G - 1) / G : 0;
      for (int idx = tid; idx < nmine * 64; idx += NTHR) { const int bt = bid + (idx >> 6) * G, rI = idx & 63;
          const int tok = bt * 16 + (rI >> 2), k = rI & 3; const int e = TKE[(size_t)tok * 4 + k]; const int pos = basev[e] + POS[(size_t)tok * 4 + k];
          POS[(size_t)tok * 4 + k] = pos; LIST[(size_t)e * NT0 + pos] = tok; } }
}

__device__ __forceinline__ void phase_conv(const Params& p, int bid, int G, const int wvi) {
    unsigned char* const ws = launder_ptr(p.ws);
    const unsigned char* UP = (const unsigned char*)(ws + WS_Z); bf16_t* U = (bf16_t*)(ws + WS_U);
    const int tid = my_tid(wvi);
    const float* cw = kin(11); const float* cb = kin(12);
    const int ch = (tid & 127) * 8;
    f32x4 wk[4][2], bsv[2];
#pragma unroll
    for (int k = 0; k < 4; ++k) { wk[k][0] = *(const f32x4*)(cw + k * 1024 + ch) * 0.0625f; wk[k][1] = *(const f32x4*)(cw + k * 1024 + ch + 4) * 0.0625f; }
    bsv[0] = *(const f32x4*)(cb + ch); bsv[1] = *(const f32x4*)(cb + ch + 4);
    for (int g4 = bid * 4 + (tid >> 7); g4 < NT0 / 4; g4 += G * 4) {
        const int row0 = g4 * 4;
        int pos0, len; if (row0 < NL) { pos0 = row0 & 4095; len = 4096; } else { pos0 = (row0 - NL) & 255; len = 256; }
        u32x2 x[7];
#pragma unroll
        for (int j = 0; j < 7; ++j) { const int pp = pos0 + j - 2; x[j] = (pp >= 0 && pp < len) ? *(const u32x2*)(UP + (size_t)(row0 + j - 2) * 1024 + ch) : (u32x2){0u, 0u}; }
#pragma unroll
        for (int r = 0; r < 4; ++r) {
            f32x4 a0 = bsv[0], a1 = bsv[1];
#pragma unroll
            for (int k = 0; k < 4; ++k) { const u32x2 w = x[r + k];
                a0 += wk[k][0] * unpack4_fp8(w.x); a1 += wk[k][1] * unpack4_fp8(w.y); }
            u32x4 o; o.x = cvt_pk_bf16(a0[0], a0[1]); o.y = cvt_pk_bf16(a0[2], a0[3]); o.z = cvt_pk_bf16(a1[0], a1[1]); o.w = cvt_pk_bf16(a1[2], a1[3]);
            *(u32x4*)(U + (size_t)(row0 + r) * 1024 + ch) = o;
        }
    }
}
__device__ __forceinline__ int seq_row(int b, int dir, int pp) {
    if (pp < 256) return NL + b * 256 + (dir ? 255 - pp : pp);
    const int t = pp - 256; return b * 4096 + (dir ? 4095 - t : t);
}
__device__ __forceinline__ void phase_scan_a(const Params& p, int bid, int G, const int wvi) {
    unsigned char* const ws = launder_ptr(p.ws);
    const bf16_t* LA = (const bf16_t*)(ws + WS_LA); const bf16_t* BBp = (const bf16_t*)(ws + WS_BB);
    float* AGL = (float*)(ws + WS_AGL); float* AGS = (float*)(ws + WS_AGS);
    const int tid = my_tid(wvi), sub = tid >> 8, ch = (tid & 255) * 4;
    for (int it2 = bid; it2 < 1088; it2 += G) {
        const int item = it2 * 2 + sub;
        const int b = item / 272, rem = item % 272, dir = rem / 136, c = rem % 136;
        const int rfirst = seq_row(b, dir, c * 32), rstep = dir ? -1 : 1;
        const size_t base = ((size_t)dir * NT0 + rfirst) * 1024 + ch;
        f32x4 S = (f32x4){0.f, 0.f, 0.f, 0.f}, Ls = (f32x4){0.f, 0.f, 0.f, 0.f};
#pragma unroll 1
        for (int s0 = 0; s0 < 32; s0 += 8) {
            u32x2 la[8]; unsigned bb[8];
#pragma unroll
            for (int s = 0; s < 8; ++s) { const long o = (long)base + (long)((s0 + s) * rstep) * 1024; la[s] = *(const u32x2*)(LA + o); bb[s] = *(const unsigned*)((const unsigned char*)BBp + o); }
#pragma unroll
            for (int s = 0; s < 8; ++s) { const f32x4 l = unpack4(la[s]), bv = unpack4_fp8(bb[s]) * 0.0625f;
#pragma unroll
                for (int q = 0; q < 4; ++q) { S[q] = ex2(l[q]) * S[q] + bv[q]; Ls[q] += l[q]; } }
        }
        *(f32x4*)(AGL + (size_t)item * 1024 + ch) = Ls; *(f32x4*)(AGS + (size_t)item * 1024 + ch) = S;
    }
}
__device__ __forceinline__ void phase_scan_b(const Params& p, LAS unsigned char* lds, int bid, int G, const int wvi) {
    unsigned char* const ws = launder_ptr(p.ws);
    const float* AGL = (const float*)(ws + WS_AGL); const float* AGS = (const float*)(ws + WS_AGS); float* CAR = (float*)(ws + WS_CAR);
    const int tid = my_tid(wvi), lane = tid & 63, wave = tid >> 6;
    LAS float* segA = (LAS float*)lds; LAS float* segS = segA + 512;
    for (int q = bid; q < 256; q += G) {
        const int bd = q >> 4, ch = (q & 15) * 64 + lane;
        const size_t o0 = ((size_t)bd * 136 + 17 * wave) * 1024 + ch;
        float l[17], sv[17];
#pragma unroll
        for (int c = 0; c < 17; ++c) { l[c] = AGL[o0 + (size_t)c * 1024]; sv[c] = AGS[o0 + (size_t)c * 1024]; }
        float a = 0.f, h = 0.f;
#pragma unroll
        for (int c = 0; c < 17; ++c) { a += l[c]; h = ex2(l[c]) * h + sv[c]; }
        segA[wave * 64 + lane] = a; segS[wave * 64 + lane] = h;
        __syncthreads();
        h = 0.f;
        for (int w = 0; w < wave; ++w) h = ex2(segA[w * 64 + lane]) * h + segS[w * 64 + lane];
#pragma unroll
        for (int c = 0; c < 17; ++c) { CAR[o0 + (size_t)c * 1024] = h; h = ex2(l[c]) * h + sv[c]; }
        __syncthreads();
    }
}
__device__ __forceinline__ void phase_scan_c(const Params& p, LAS unsigned char* lds, int bid, int G, const int wvi) {
    unsigned char* const ws = launder_ptr(p.ws);
    const bf16_t* LA = (const bf16_t*)(ws + WS_LA); const bf16_t* BBp = (const bf16_t*)(ws + WS_BB); const float* CAR = (const float*)(ws + WS_CAR);
    const bf16_t* GATE = (const bf16_t*)(ws + WS_GATE); bf16_t* HG = (bf16_t*)(ws + WS_HG);
    const int tid = my_tid(wvi), sub = tid >> 8, t256 = tid & 255, ch = t256 * 4;
    LAS u32x2* scr = (LAS u32x2*)lds + (size_t)sub * 32 * 256 + t256;
    for (int it2 = bid; it2 < 512; it2 += G) {
        const int item = it2 * 2 + sub, b = item >> 7, j = item & 127;
        const size_t row0 = (size_t)b * 4096 + 32 * j;
        f32x4 h = *(const f32x4*)(CAR + ((size_t)(b * 2 + 1) * 136 + (135 - j)) * 1024 + ch);
#pragma unroll 1
        for (int t0 = 24; t0 >= 0; t0 -= 8) {
            u32x2 la[8]; unsigned bb[8];
#pragma unroll
            for (int s = 0; s < 8; ++s) { const size_t o = ((size_t)NT0 + row0 + t0 + s) * 1024 + ch; la[s] = *(const u32x2*)(LA + o); bb[s] = *(const unsigned*)((const unsigned char*)BBp + o); }
#pragma unroll
            for (int s = 7; s >= 0; --s) { const f32x4 l = unpack4(la[s]), bv = unpack4_fp8(bb[s]) * 0.0625f;
#pragma unroll
                for (int q = 0; q < 4; ++q) h[q] = ex2(l[q]) * h[q] + bv[q];
                scr[(t0 + s) * 256] = pack4(h); }
        }
        h = *(const f32x4*)(CAR + ((size_t)(b * 2 + 0) * 136 + (8 + j)) * 1024 + ch);
#pragma unroll 1
        for (int t0 = 0; t0 < 32; t0 += 8) {
            u32x2 la[8], gt[8]; unsigned bb[8];
#pragma unroll
            for (int s = 0; s < 8; ++s) { const size_t o = (row0 + t0 + s) * 1024 + ch; la[s] = *(const u32x2*)(LA + o); bb[s] = *(const unsigned*)((const unsigned char*)BBp + o); gt[s] = *(const u32x2*)(GATE + o); }
#pragma unroll
            for (int s = 0; s < 8; ++s) { const f32x4 l = unpack4(la[s]), bv = unpack4_fp8(bb[s]) * 0.0625f;
#pragma unroll
                for (int q = 0; q < 4; ++q) h[q] = ex2(l[q]) * h[q] + bv[q];
                const f32x4 rec = h + unpack4(scr[(t0 + s) * 256]);
                *(u32x2*)(HG + (row0 + t0 + s) * 1024 + ch) = pack4(unpack4(gt[s]) * rec); }
        }
    }
}


#define XB_TMO      128
#define XB_XCNT(j)  (256  + 64 * (j))
#define XB_XSUB(j)  (1280 + 64 * (j))
#define XB_XGEN(j)  (2304 + 64 * (j))
#define XB_TOP      3328
#define XB_TOPGEN   3392
#define XCD_BAR_WORDS 3456
#define XB_SPIN_CAP (1u << 21)
__device__ __forceinline__ unsigned xb_ld(unsigned* p)              { return __hip_atomic_load(p, __ATOMIC_RELAXED, __HIP_MEMORY_SCOPE_AGENT); }
__device__ __forceinline__ unsigned xb_add(unsigned* p, unsigned v) { return __hip_atomic_fetch_add(p, v, __ATOMIC_RELAXED, __HIP_MEMORY_SCOPE_AGENT); }
__device__ __forceinline__ unsigned xb_xcc_id() { return (unsigned)__builtin_amdgcn_s_getreg((3 << 11) | 20) & 0xFu; }
#define XB_SPIN(cond, bar) do { unsigned _sp = 0; while (cond) { __builtin_amdgcn_s_sleep(1); \
    if ((++_sp & 255u) == 0u) { if (xb_ld(&(bar)[XB_TMO])) break; if (_sp > XB_SPIN_CAP) { atomicAdd(&(bar)[XB_TMO], 1u); break; } } } } while (0)
struct XcdBarrier { unsigned* bar; unsigned x; volatile LAS unsigned* st; };
__device__ __forceinline__ XcdBarrier xcd_barrier_post(unsigned* bar, volatile LAS unsigned* st, const bool t0) {
    XcdBarrier b; b.bar = bar; b.x = xb_xcc_id(); b.st = st;
    if (t0) (void)xb_add(&bar[XB_XCNT(b.x)], 1u);
    return b;
}
__device__ __forceinline__ void xcd_barrier_complete(unsigned* bar, unsigned x, unsigned& nloc, unsigned& nx) {
    const unsigned G = gridDim.x * gridDim.y * gridDim.z;
    unsigned sum, cnt, mine, sp = 0u;
    for (;;) {
        sum = 0u; cnt = 0u; mine = 0u;
#pragma unroll
        for (unsigned j = 0; j < 16; ++j) { const unsigned c = xb_ld(&bar[XB_XCNT(j)]); sum += c; cnt += (c > 0u) ? 1u : 0u; mine = (j == x) ? c : mine; }
        if (sum == G) break;
        __builtin_amdgcn_s_sleep(1);
        if ((++sp & 255u) == 0u) { if (xb_ld(&bar[XB_TMO])) break; if (sp > XB_SPIN_CAP) { atomicAdd(&bar[XB_TMO], 1u); break; } }
    }
    nloc = mine > 0u ? mine : 1u; nx = cnt > 0u ? cnt : 1u;
}
__device__ __forceinline__ void xcd_barrier(const XcdBarrier& b, const int wvi) {
    asm volatile("s_waitcnt vmcnt(0)" ::: "memory");
    __syncthreads();
    if (my_tid(wvi) == 0) {
        unsigned* bar = b.bar;
        __builtin_amdgcn_s_waitcnt(0);
        unsigned nloc = b.st[0], nx = b.st[1];
        if (nloc == 0u) { xcd_barrier_complete(bar, b.x, nloc, nx); b.st[0] = nloc; b.st[1] = nx; }
        const unsigned old = xb_add(&bar[XB_XSUB(b.x)], 1u);
        const unsigned gen = old / nloc;
        if (old + 1u == (gen + 1u) * nloc) {
            __builtin_amdgcn_fence(__ATOMIC_RELEASE, "agent");
            asm volatile("s_waitcnt vmcnt(0)" ::: "memory");
            const unsigned og = xb_add(&bar[XB_TOP], 1u);
            const unsigned tg = og / nx;
            if (og + 1u == (tg + 1u) * nx) xb_add(&bar[XB_TOPGEN], 1u);
            else XB_SPIN(xb_ld(&bar[XB_TOPGEN]) == tg, bar);
            __builtin_amdgcn_fence(__ATOMIC_ACQUIRE, "agent");
            xb_add(&bar[XB_XGEN(b.x)], 1u);
            asm volatile("s_waitcnt vmcnt(0)" ::: "memory");
        } else {
            XB_SPIN(xb_ld(&bar[XB_XGEN(b.x)]) == gen, bar);
            __builtin_amdgcn_fence(__ATOMIC_ACQUIRE, "agent");
            asm volatile("s_waitcnt vmcnt(0)" ::: "memory");
        }
    }
    __syncthreads();
}

__device__ __forceinline__ void run_phase(const Params& p, LAS unsigned char* lds, int ph, int bid, int vid, int G, const int wvi) {
    asm volatile("" : "+s"(bid), "+s"(vid), "+s"(G));
    unsigned char* const ws = launder_ptr(p.ws);
    LAS int* tab = (LAS int*)(lds + pg8::STAGE_BYTES);
    const float* mod = (const float*)(ws + WS_MOD);
#define GEMM_DONE(slot) do { if (my_tid(wvi) == 0) __hip_atomic_fetch_add((unsigned*)(ws + WS_CTL + CTL_DONE + 64 * (slot)), 1u, __ATOMIC_RELAXED, __HIP_MEMORY_SCOPE_AGENT); } while (0)
    switch (ph) {
    case 0: phase_prep(p, lds, bid, G, wvi); break;
    case 1: phase_norm0(p, bid, G, wvi); break;
    case 2: { int Gg, ns; const int gi = gemm_split(136 * 4, vid, G, Gg, ns);
              if (gi >= 0) { ProbPool P{(unsigned)WS_H, 256, (unsigned)WS_WPOOL, (bf16_t*)(ws + WS_Z)}; pg8::gemm_phase<256, true>(lds, (const char*)ws, P, gi, Gg, wvi); GEMM_DONE(3); }
              else weight_queue(p, lds, wvi, 3, (unsigned)ns, bid, G); } break;
    case 3: phase_pool(p, lds, bid, G, wvi); break;
    case 4: router_phase(p, lds, bid, G, NT0, kin(7), 0, 3072, 0, wvi); break;
    case 5: { moe_table(tab, (const int*)(ws + WS_CTL + CTL_CNT), wvi);
              int Gg, ns; const int gi = gemm_split(8 * __builtin_amdgcn_readfirstlane(tab[32]), vid, G, Gg, ns);
              if (gi >= 0) { ProbMoe1 P{(unsigned)WS_H8, 512, (unsigned)WS_WGU, tab, (const int*)(ws + WS_LIST), kin(22), (bf16_t*)(ws + WS_ACT)}; pg8::gemm_phase_p<512, true, true, true>(lds, (const char*)ws, P, gi, Gg, wvi); GEMM_DONE(4); }
              else { __syncthreads(); weight_queue(p, lds, wvi, 4, (unsigned)ns, bid, G); } } break;
    case 6: { moe_table(tab, (const int*)(ws + WS_CTL + CTL_CNT), wvi);
              int Gg, ns; const int gi = gemm_split(4 * __builtin_amdgcn_readfirstlane(tab[32]), vid, G, Gg, ns);
              if (gi >= 0) { ProbMoe2 P{(unsigned)WS_ACT, 512, (unsigned)WS_WDN, tab, kin(24), (bf16_t*)(ws + WS_OUTB)}; pg8::gemm_phase_p<512, true, true, true>(lds, (const char*)ws, P, gi, Gg, wvi); GEMM_DONE(0); }
              else { __syncthreads(); weight_queue(p, lds, wvi, 0, (unsigned)ns, bid, G); } } break;
    case 7: combine_phase<false>(p, lds, bid, G, NT0, kin(6) + 1024, 1, 0, 0, wvi); break;
    case 8: { int Gg, ns; const int gi = gemm_split(1056, vid, G, Gg, ns);
              if (gi >= 0) { ProbIn P{(unsigned)WS_H, 1024, (unsigned)WS_WIN, (bf16_t*)(ws + WS_GATE), (bf16_t*)(ws + WS_Z)}; pg8::gemm_phase<1024, true>(lds, (const char*)ws, P, gi, Gg, wvi); GEMM_DONE(1); }
              else weight_queue(p, lds, wvi, 1, (unsigned)ns, bid, G); } break;
    case 9: phase_conv(p, bid, G, wvi); break;
    case 10: { int Gg, ns; const int gi = gemm_split(136 * 16, vid, G, Gg, ns);
               if (gi >= 0) { ProbGate P{(unsigned)WS_U, 256, (unsigned)WS_WGATE, (const bf16_t*)(ws + WS_U), kin(14), kin(16), (const float*)(ws + WS_CTL + CTL_SP8), (bf16_t*)(ws + WS_LA), (bf16_t*)(ws + WS_BB)};
                              pg8::gemm_phase<256, true>(lds, (const char*)ws, P, gi, Gg, wvi); GEMM_DONE(2); }
               else weight_queue(p, lds, wvi, 2, (unsigned)ns, bid, G); } break;
    case 11: phase_scan_a(p, bid, G, wvi); break;
    case 12: phase_scan_b(p, lds, bid, G, wvi); break;
    case 13: phase_scan_c(p, lds, bid, G, wvi); break;
    case 14: { ProbOut P{(unsigned)WS_HG, 1024, (unsigned)WS_WOUT, mod + (size_t)9 * 6144 + 2048, (bf16_t*)(ws + WS_LAT)}; pg8::gemm_phase<1024, false>(lds, (const char*)ws, P, vid, G, wvi); } break;
    case 15: router_phase(p, lds, bid, G, NL, kin(7) + 1024, 1, 3072, 1, wvi); __syncthreads(); weight_queue(p, lds, wvi, -1, 0u, bid, G); break;
    case 16: { moe_table(tab, (const int*)(ws + WS_CTL + CTL_CNT + 256), wvi);
               ProbMoe1 P{(unsigned)WS_H8, 512, (unsigned)(WS_WGU + (size_t)32 * 2048 * 1024), tab, (const int*)(ws + WS_LIST), kin(22) + 32 * 2048, (bf16_t*)(ws + WS_ACT)}; pg8::gemm_phase_p<512, true, true, true>(lds, (const char*)ws, P, vid, G, wvi); } break;
    case 17: { moe_table(tab, (const int*)(ws + WS_CTL + CTL_CNT + 256), wvi);
               ProbMoe2 P{(unsigned)WS_ACT, 512, (unsigned)(WS_WDN + (size_t)32 * 1024 * 1024), tab, kin(24) + 32 * 1024, (bf16_t*)(ws + WS_OUTB)}; pg8::gemm_phase_p<512, true, true, true>(lds, (const char*)ws, P, vid, G, wvi); } break;
    case 18: combine_phase<true>(p, lds, bid, G, NL, kin(25), 0, 0, 1, wvi); break;
#ifdef PROBE_ABL
    case 21: { moe_table(tab, (const int*)(ws + WS_CTL + CTL_CNT), wvi);
              ProbMoe1 P{(unsigned)WS_H8, 512, (unsigned)WS_WGU, tab, (const int*)(ws + WS_LIST), kin(22), (bf16_t*)(ws + WS_END)}; pg8::gemm_phase<512, true, PROBE_ABL, true>(lds, (const char*)ws, P, vid, G, wvi); } break;
#endif
    default: break;
    }
}

__global__ void __launch_bounds__(512, 2) mega(Params p) {
    extern __shared__ __attribute__((aligned(16))) unsigned char shm[];
    LAS unsigned char* lds = (LAS unsigned char*)shm;
    const int G = gridDim.x, bid = blockIdx.x;
    const int vid = (G & 7) ? bid : ((bid & 7) * (G >> 3) + (bid >> 3));
    volatile LAS unsigned* xst = (volatile LAS unsigned*)(lds + LDS_BYTES - 16);
    const int wvi = __builtin_amdgcn_readfirstlane((int)(threadIdx.x >> 6));
    if (threadIdx.x == 0) { xst[0] = 0u; xst[1] = 0u; }
    __syncthreads();
    XcdBarrier xb = xcd_barrier_post((unsigned*)(p.ws + WS_CTL), xst, threadIdx.x == 0);
    if (p.ph_hi > 1000) cg::this_grid().sync();
    for (int ph = p.ph_lo; ph < p.ph_hi; ++ph) {
#if defined(PROBE_ABL)
        run_phase(p, lds, ph <= 5 ? ph : (ph == 6 ? 21 : ph - 1), bid, vid, G, wvi);
#elif defined(PROBE_DUP)
        run_phase(p, lds, ph <= PROBE_DUP ? ph : (ph <= PROBE_DUP + PROBE_REPS ? PROBE_DUP : ph - PROBE_REPS), bid, vid, G, wvi);
#else
        run_phase(p, lds, ph, bid, vid, G, wvi);
#endif
        if (ph + 1 < p.ph_hi) xcd_barrier(xb, wvi);
    }
}

extern "C" void kernel_launch(void* const* d_in, const int* in_sizes, int n_in, void* d_out, int out_size, void* d_ws, size_t ws_size, hipStream_t stream) {
    static int grid = 0;
    if (grid == 0) {
        if (n_in != 26 || ws_size < WS_END) { fprintf(stderr, "kernel_launch: unexpected inputs (n_in %d, ws %zu, need %zu)\n", n_in, ws_size, (size_t)WS_END); grid = -1; return; }
        int dev = 0, cus = 0;
        if (hipGetDevice(&dev) != hipSuccess || hipDeviceGetAttribute(&cus, hipDeviceAttributeMultiprocessorCount, dev) != hipSuccess) { grid = -1; return; }
        if (hipFuncSetAttribute((const void*)mega, hipFuncAttributeMaxDynamicSharedMemorySize, LDS_BYTES) != hipSuccess) { fprintf(stderr, "kernel_launch: hipFuncSetAttribute failed\n"); grid = -1; return; }
        int per_cu = 0;
        if (hipOccupancyMaxActiveBlocksPerMultiprocessor(&per_cu, (const void*)mega, NTHR, LDS_BYTES) != hipSuccess || per_cu < 1) { fprintf(stderr, "kernel_launch: occupancy query says %d blocks per CU\n", per_cu); (void)hipGetLastError(); }
        grid = (cus < 256 ? cus : 256) & ~7;
        if (grid < 8) { fprintf(stderr, "kernel_launch: too few CUs (%d)\n", cus); grid = -1; return; }
    }
    if (grid < 0) return;
    (void)hipMemsetAsync((char*)d_ws + WS_CTL, 0, 65536, stream);
    Params p{};
    for (int i = 0; i < 26; ++i) p.in[i] = (const float*)d_in[i];
    p.out = (float*)d_out; p.ws = (unsigned char*)d_ws;
#if N_LAUNCH_MODE == 0
    for (int ph = 0; ph < NPHASE; ++ph) { p.ph_lo = ph; p.ph_hi = ph + 1; hipLaunchKernelGGL(mega, dim3(grid), dim3(NTHR), LDS_BYTES, stream, p); }
#else
#if defined(PROBE_DUP)
    p.ph_lo = 0; p.ph_hi = NPHASE + PROBE_REPS;
#elif defined(PROBE_ABL)
    p.ph_lo = 0; p.ph_hi = NPHASE + 1;
#else
    p.ph_lo = 0; p.ph_hi = NPHASE;
#endif
    void* args[] = {&p};
    hipError_t e = hipLaunchCooperativeKernel((const void*)mega, dim3(grid), dim3(NTHR), args, LDS_BYTES, stream);
    if (e != hipSuccess) fprintf(stderr, "cooperative launch failed: %s (grid %d)\n", hipGetErrorString(e), grid);
#endif
}
```
